# Optimizing an MI355X kernel written in HIP

```python
import math
import jax, jax.numpy as jnp
from jax import lax
import numpy as np

D_MODEL = 1024
BATCH = 4
SEQ = 8192
DEPTH = 4

N_META = 16
D_MIX = D_MODEL
ATTN_WIDTH = D_MIX // 2
CONV_CH = D_MIX - ATTN_WIDTH
N_ATTN_HEADS = 4
V_HEAD_DIM = ATTN_WIDTH // N_ATTN_HEADS
HEAD_DIM = V_HEAD_DIM // 2
QK_WIDTH = N_ATTN_HEADS * 2 * HEAD_DIM
IN_WIDTH = 2 * QK_WIDTH + ATTN_WIDTH + 2 * CONV_CH
CONV_WIDTH = 31
D_FF = -(-8 * D_MODEL // (3 * 256)) * 256
ROPE_THETA = 10000.0
Q_BLOCK = 128
NORM_EPS = 1e-5

kernel_name = "hybrid_diffattn_conformer_conv_swiglu"


def rmsnorm(x, g):
    x32 = x.astype(jnp.float32)
    y = x32 * lax.rsqrt(jnp.mean(x32 * x32, axis=-1, keepdims=True) + NORM_EPS)
    return (y * g.astype(jnp.float32)).astype(x.dtype)


def layer_norm(x, g, b):
    x32 = x.astype(jnp.float32)
    mu = jnp.mean(x32, axis=-1, keepdims=True)
    xc = x32 - mu
    y = xc * lax.rsqrt(jnp.mean(xc * xc, axis=-1, keepdims=True) + NORM_EPS)
    return (y * g.astype(jnp.float32) + b.astype(jnp.float32)).astype(x.dtype)


def rope_tables(length, dtype):
    pos = jnp.arange(length, dtype=jnp.float32)
    inv = ROPE_THETA ** (-jnp.arange(0, HEAD_DIM, 2, dtype=jnp.float32) / HEAD_DIM)
    ang = pos[:, None] * inv[None, :]
    ang = jnp.concatenate([ang, ang], axis=-1)
    return jnp.cos(ang).astype(dtype), jnp.sin(ang).astype(dtype)


def apply_rope(t, cos, sin):
    c = cos[None, :, None, None, :]
    s = sin[None, :, None, None, :]
    t1, t2 = jnp.split(t, 2, axis=-1)
    return t * c + jnp.concatenate([-t2, t1], axis=-1) * s


def diff_attention(q, k, v, lam, sub_g, lam_init):
    B, L = q.shape[0], q.shape[1]
    n_blk = -(-L // Q_BLOCK)
    L_pad = n_blk * Q_BLOCK
    pad = L_pad - L
    q = jnp.pad(q, ((0, 0), (0, pad), (0, 0), (0, 0), (0, 0)))
    k = jnp.pad(k, ((0, 0), (0, pad), (0, 0), (0, 0), (0, 0)))
    v = jnp.pad(v, ((0, 0), (0, pad), (0, 0), (0, 0)))
    qb = q.reshape(B, n_blk, Q_BLOCK, N_ATTN_HEADS, 2, HEAD_DIM).transpose(1, 0, 2, 3, 4, 5)
    k_pos = jnp.arange(L_pad)
    scale = HEAD_DIM ** -0.5

    def one_block(args):
        q_blk, start = args
        s = jnp.einsum('bqhcd,bkhcd->bhcqk', q_blk, k).astype(jnp.float32) * scale
        q_pos = start + jnp.arange(Q_BLOCK)
        mask = k_pos[None, :] <= q_pos[:, None]
        s = jnp.where(mask, s, -jnp.inf)
        p = jax.nn.softmax(s, axis=-1)
        a = p[:, :, 0] - lam * p[:, :, 1]
        return jnp.einsum('bhqk,bkhe->bqhe', a.astype(v.dtype), v)

    starts = jnp.arange(n_blk) * Q_BLOCK
    o = lax.map(one_block, (qb, starts))
    o = o.transpose(1, 0, 2, 3, 4).reshape(B, L_pad, N_ATTN_HEADS, V_HEAD_DIM)[:, :L]
    o = rmsnorm(o, sub_g) * (1.0 - lam_init)
    return o.reshape(B, L, ATTN_WIDTH)


def conformer_conv(u, conv_w, conv_b, ln_g, ln_b):
    a, gate = jnp.split(u, 2, axis=-1)
    z = a * jax.nn.sigmoid(gate)
    z = lax.conv_general_dilated(
        z, conv_w[:, None, :], window_strides=(1,), padding=((CONV_WIDTH - 1, 0),),
        dimension_numbers=('NWC', 'WIO', 'NWC'), feature_group_count=CONV_CH)
    z = z + conv_b
    z = layer_norm(z, ln_g, ln_b)
    return jax.nn.silu(z)


def setup_inputs(seed: int = 0) -> dict:
    key = jax.random.key(seed)
    ks = jax.random.split(key, 20)
    f = jnp.float32
    nrm = lambda k, shape, s: jax.random.normal(k, shape, f) * s
    return {
        "x": nrm(ks[0], (BATCH, SEQ, D_MODEL), 1.0),
        "meta_tokens": nrm(ks[1], (N_META, D_MODEL), 1.0),
        "norm1_g": 1.0 + nrm(ks[2], (DEPTH, D_MODEL), 0.02),
        "w_in": nrm(ks[3], (DEPTH, D_MODEL, IN_WIDTH), D_MODEL ** -0.5),
        "b_glu": nrm(ks[4], (DEPTH, 2 * CONV_CH), 0.02),
        "conv_w": nrm(ks[5], (DEPTH, CONV_WIDTH, CONV_CH), CONV_WIDTH ** -0.5),
        "conv_b": nrm(ks[6], (DEPTH, CONV_CH), 0.02),
        "conv_ln_g": 1.0 + nrm(ks[7], (DEPTH, CONV_CH), 0.02),
        "conv_ln_b": nrm(ks[8], (DEPTH, CONV_CH), 0.02),
        "lam_q1": nrm(ks[9], (DEPTH, HEAD_DIM), 0.1),
        "lam_k1": nrm(ks[10], (DEPTH, HEAD_DIM), 0.1),
        "lam_q2": nrm(ks[11], (DEPTH, HEAD_DIM), 0.1),
        "lam_k2": nrm(ks[12], (DEPTH, HEAD_DIM), 0.1),
        "subln_g": 1.0 + nrm(ks[13], (DEPTH, V_HEAD_DIM), 0.02),
        "w_out": nrm(ks[14], (DEPTH, D_MIX, D_MODEL), D_MIX ** -0.5),
        "norm2_g": 1.0 + nrm(ks[15], (DEPTH, D_MODEL), 0.02),
        "w_gate_up": nrm(ks[16], (DEPTH, D_MODEL, 2 * D_FF), D_MODEL ** -0.5),
        "w_down": nrm(ks[17], (DEPTH, D_FF, D_MODEL), D_FF ** -0.5),
        "final_g": 1.0 + nrm(ks[18], (D_MODEL,), 0.02),
    }


def reference(x, meta_tokens, norm1_g, w_in, b_glu, conv_w, conv_b, conv_ln_g, conv_ln_b,
              lam_q1, lam_k1, lam_q2, lam_k2, subln_g, w_out, norm2_g, w_gate_up, w_down,
              final_g):
    B, S, D = x.shape
    meta = jnp.broadcast_to(meta_tokens[None].astype(x.dtype), (B, N_META, D))
    h = jnp.concatenate([meta, x], axis=1)
    L = S + N_META
    cos, sin = rope_tables(L, x.dtype)
    for l in range(DEPTH):
        lam_init = 0.8 - 0.6 * math.exp(-0.3 * l)
        hn = rmsnorm(h, norm1_g[l])
        proj = hn @ w_in[l]
        q, k, v, u = jnp.split(proj, [QK_WIDTH, 2 * QK_WIDTH, 2 * QK_WIDTH + ATTN_WIDTH], axis=-1)
        q = apply_rope(q.reshape(B, L, N_ATTN_HEADS, 2, HEAD_DIM), cos, sin)
        k = apply_rope(k.reshape(B, L, N_ATTN_HEADS, 2, HEAD_DIM), cos, sin)
        v = v.reshape(B, L, N_ATTN_HEADS, V_HEAD_DIM)
        lam = (jnp.exp(jnp.sum(lam_q1[l].astype(jnp.float32) * lam_k1[l].astype(jnp.float32)))
               - jnp.exp(jnp.sum(lam_q2[l].astype(jnp.float32) * lam_k2[l].astype(jnp.float32)))
               + lam_init)
        attn_out = diff_attention(q, k, v, lam, subln_g[l], lam_init)
        conv_out = conformer_conv(u + b_glu[l], conv_w[l], conv_b[l],
                                  conv_ln_g[l], conv_ln_b[l])
        h = h + jnp.concatenate([attn_out, conv_out], axis=-1) @ w_out[l]
        hn = rmsnorm(h, norm2_g[l])
        gate, up = jnp.split(hn @ w_gate_up[l], 2, axis=-1)
        h = h + (jax.nn.silu(gate) * up) @ w_down[l]
    h = rmsnorm(h, final_g)
    return h[:, N_META:]
```

```cpp
#include <hip/hip_runtime.h>
#include <hip/hip_cooperative_groups.h>
#include <cstdio>
#include <cstdint>
constexpr int NB = 4, SEQ = 8192, DMODEL = 1024, NMETA = 16, DEPTH = 4;
constexpr int MX = NB * SEQ;
constexpr int MROWS = MX + 256;
constexpr int NIN = 2560, DFF = 2816, NGU = 2 * DFF, CONVW = 31, CCH = 512;
constexpr int NPHASE = 2 + 6 * DEPTH;
constexpr size_t al4k(size_t x) { return (x + 4095) & ~(size_t)4095; }
constexpr size_t OFF_CTL = 0, SZ_CTL = 1u << 20;
constexpr size_t SZ_ROPE = al4k((size_t)(SEQ + NMETA) * 32 * 4);
constexpr size_t OFF_ROPEC = OFF_CTL + SZ_CTL, OFF_ROPES = OFF_ROPEC + SZ_ROPE;
constexpr size_t OFF_SS = OFF_ROPES + SZ_ROPE, SZ_SS = al4k((size_t)MROWS * 16 * 4);
constexpr size_t SZ_WIN = (size_t)NIN * 1024 * 2, SZ_WOUT = (size_t)1024 * 1024 * 2, SZ_WGU = (size_t)NGU * 1024 * 2, SZ_WDN = (size_t)1024 * DFF * 2;
constexpr size_t SZ_WL = SZ_WIN + SZ_WOUT + SZ_WGU + SZ_WDN;
constexpr size_t OFF_W = OFF_SS + SZ_SS;
constexpr size_t OFF_H = OFF_W + DEPTH * SZ_WL, SZ_H = (size_t)MROWS * 1024 * 4;
constexpr size_t OFF_HB = OFF_H + SZ_H, SZ_HB = (size_t)MROWS * 1024 * 2;
constexpr size_t SZ_QK = (size_t)MROWS * 512 * 2;
constexpr size_t OFF_Q = OFF_HB + SZ_HB, OFF_K = OFF_Q + SZ_QK, OFF_V = OFF_K + SZ_QK, OFF_Z = OFF_V + SZ_QK, OFF_O = OFF_Z + SZ_QK;
constexpr size_t WS_END = OFF_O + (size_t)MROWS * 1024 * 2;
constexpr size_t OFF_MIX = OFF_Q;
constexpr size_t OFF_ACT = OFF_Q;
static_assert(OFF_ACT + (size_t)MROWS * DFF * 2 <= WS_END && WS_END <= ((size_t)512 << 20), "d_ws map");
constexpr int CW_LAM = 64;
namespace pg8 { constexpr size_t EO_Q = OFF_Q, EO_K = OFF_K, EO_V = OFF_V, EO_Z = OFF_Z, EO_SS = OFF_SS, EO_RC = OFF_ROPEC, EO_RS = OFF_ROPES, EO_H = OFF_H, EO_HB = OFF_HB, EO_ACT = OFF_ACT; }
namespace pg8 {
#define PG8_LAS __attribute__((address_space(3)))
typedef unsigned short bf16_t;
typedef short bf16x8 __attribute__((ext_vector_type(8)));
typedef float f32x4 __attribute__((ext_vector_type(4)));
typedef unsigned u32x4 __attribute__((ext_vector_type(4)));
constexpr int BM = 256, BK = 64, HALF = 128, HTB = HALF * BK * 2  , STAGE_BYTES = 8 * HTB, NXCD = 8, WGM = 8;

__host__ __device__ __forceinline__ int lds_byte(int r, int c) { const int st = (r >> 4) * 2 + (c >> 5), rr = r & 15, cc = c & 31, ob = rr * 64 + cc * 2; return st * 1024 + (ob ^ (((ob >> 9) & 1) << 5)); }
__host__ __device__ __forceinline__ void stage_rc(int b, int& R, int& C) { const int st = b / 1024, sb = b % 1024, swz = sb ^ (((sb >> 9) & 1) << 5); R = (st >> 1) * 16 + swz / 64; C = (st & 1) * 32 + (swz % 64) / 2; }
__host__ __device__ __forceinline__ int perm32(int rho) { const int n = rho >> 4, i = rho & 15; return 8 * (i >> 2) + 4 * n + (i & 3); }

struct Unit { int pm, pn; };
struct Gemm { const bf16_t* A; const bf16_t* Bt; int M, N, K; };

struct StaticOrder {
    int nM, nN, nwg, G, c;
    __host__ __device__ void init(int M, int N, int G_, int c_) { nM = M / BM; nN = N / BM; nwg = nM * nN; G = G_; c = c_; }
    int rep = 1;
    __host__ __device__ bool next(int i, Unit& u) const {
        i = i / rep; const long L = (long)i * G + c; if (L >= nwg) return false;
        int wgid = (int)L; { const int q = nwg / NXCD, r = nwg % NXCD, xcd = wgid % NXCD, off = wgid / NXCD; wgid = (xcd < r ? xcd * (q + 1) : r * (q + 1) + (xcd - r) * q) + off; }
        const int nig = WGM * nN, gid = wgid / nig, fm = gid * WGM, gsz = (nM - fm) < WGM ? (nM - fm) : WGM;
        u.pm = fm + ((wgid % nig) % gsz); u.pn = (wgid % nig) / gsz; return true;
    }
    __device__ __forceinline__ void a_ready(const Unit&) const {}
    __device__ __forceinline__ void done(const Unit&) const {}
};


__device__ __forceinline__ unsigned cvt_pk_bf16(float lo, float hi) { unsigned r; asm volatile("v_cvt_pk_bf16_f32 %0, %1, %2" : "=v"(r) : "v"(lo), "v"(hi)); return r; }
#ifndef PG8_NT_STORE
#define PG8_NT_STORE 0
#endif
__device__ __forceinline__ void store8(bf16_t* p, const f32x4 a, const f32x4 b) {
    u32x4 w; w.x = cvt_pk_bf16(a[0], a[1]); w.y = cvt_pk_bf16(a[2], a[3]); w.z = cvt_pk_bf16(b[0], b[1]); w.w = cvt_pk_bf16(b[2], b[3]);
#if PG8_NT_STORE
    __builtin_nontemporal_store(w, (u32x4*)p);
#else
    *(u32x4*)p = w;
#endif
}
constexpr int MXROWS = 32768;
constexpr float RMS_EPS = 1e-5f;
constexpr float QC2 = 0.125f * 1.4426950408889634f;
__device__ __forceinline__ float row_rstd(const float* SS, int row) {
    const f32x4* p = (const f32x4*)(SS + (size_t)row * 16);
    const f32x4 a = p[0], b = p[1], c = p[2], d = p[3];
    const float s = (((a[0] + a[1]) + (a[2] + a[3])) + ((b[0] + b[1]) + (b[2] + b[3]))) + (((c[0] + c[1]) + (c[2] + c[3])) + ((d[0] + d[1]) + (d[2] + d[3])));
    return __builtin_amdgcn_rsqf(s * (1.0f / 1024.0f) + RMS_EPS);
}
__device__ __forceinline__ f32x4 sigmoid4(const f32x4 g) {
    f32x4 r; r[0] = __builtin_amdgcn_rcpf(1.f + __expf(-g[0])); r[1] = __builtin_amdgcn_rcpf(1.f + __expf(-g[1])); r[2] = __builtin_amdgcn_rcpf(1.f + __expf(-g[2])); r[3] = __builtin_amdgcn_rcpf(1.f + __expf(-g[3])); return r; }

#define PG8_EPI_LOOP_RS() \
    __device__ __forceinline__ void operator()(const f32x4 (&acc)[2][2][4][2], const Unit& u, int wr, int wc, int fr, int fq, int ui) const { \
        const int row0 = u.pm * BM + wr * 64 + fr; const PG8_LAS float* rl = RL + ui * BM + wr * 64 + fr; \
        _Pragma("unroll") for (int ai = 0; ai < 2; ++ai) _Pragma("unroll") for (int m = 0; m < 4; ++m) \
            rgs(acc[ai][0][m][0], acc[ai][0][m][1], acc[ai][1][m][0], acc[ai][1][m][1], row0 + ai * HALF + m * 16, u.pn, wc, fq, rl[ai * HALF + m * 16]); }

struct EpiQKVZ {
    static constexpr bool PERM = true, AFTER_DRAIN = false;
    bf16_t *Q, *K, *V, *Z; const float* SS; const float* RC; const float* RS; const float* bglu; const PG8_LAS float* RL;
    __device__ __forceinline__ void rg(const f32x4 a00, const f32x4 a01, const f32x4 a10, const f32x4 a11, int row, int pn, int wc, int fq) const { rgs(a00, a01, a10, a11, row, pn, wc, fq, row_rstd(SS, row)); }
    __device__ __forceinline__ void rgs(const f32x4 a00, const f32x4 a01, const f32x4 a10, const f32x4 a11, int row, int pn, int wc, int fq, const float rs0) const {
        if (pn < 4) {
            bf16_t* dst = (pn < 2) ? Q : K; const float sc = (pn < 2) ? QC2 : 1.f; const int colb = ((pn & 1) * 4 + wc) * 64 + 8 * fq;
            const float rs = rs0 * sc;
            const int pos = row < MXROWS ? 16 + (row & 8191) : row - MXROWS;
            const f32x4 c0 = *(const f32x4*)(RC + pos * 32 + 8 * fq), c1 = *(const f32x4*)(RC + pos * 32 + 8 * fq + 4);
            const f32x4 s0 = *(const f32x4*)(RS + pos * 32 + 8 * fq), s1 = *(const f32x4*)(RS + pos * 32 + 8 * fq + 4);
            const f32x4 x1a = a00 * rs, x1b = a01 * rs, x2a = a10 * rs, x2b = a11 * rs;
            store8(dst + (size_t)row * 512 + colb, x1a * c0 - x2a * s0, x1b * c1 - x2b * s1);
            store8(dst + (size_t)row * 512 + colb + 32, x2a * c0 + x1a * s0, x2b * c1 + x1b * s1);
        } else if (pn < 6) {
            const int col0 = (pn - 4) * BM + wc * 32 + 8 * fq; const float rs = rs0;
            store8(V + (size_t)row * 512 + col0, a00 * rs, a01 * rs); store8(V + (size_t)row * 512 + col0 + HALF, a10 * rs, a11 * rs);
        } else {
            const int cc = (pn - 6) * HALF + wc * 32 + 8 * fq; const float rs = rs0;
            const f32x4 ba0 = *(const f32x4*)(bglu + cc), ba1 = *(const f32x4*)(bglu + cc + 4), bg0 = *(const f32x4*)(bglu + 512 + cc), bg1 = *(const f32x4*)(bglu + 512 + cc + 4);
            const f32x4 x0 = a00 * rs + ba0, x1 = a01 * rs + ba1, g0 = a10 * rs + bg0, g1 = a11 * rs + bg1;
            store8(Z + (size_t)row * 512 + cc, x0 * sigmoid4(g0), x1 * sigmoid4(g1));
        }
    }
    __device__ __forceinline__ void operator()(const f32x4 (&acc)[2][2][4][2], const Unit& u, int wr, int wc, int fr, int fq, int ui) const {
        const int row0 = u.pm * BM + wr * 64 + fr, pn = u.pn; const PG8_LAS float* rl = RL + ui * BM + wr * 64 + fr;
        if (pn < 4) {
            bf16_t* dst = (pn < 2) ? Q : K; const float sc = (pn < 2) ? QC2 : 1.f; const int colb = ((pn & 1) * 4 + wc) * 64 + 8 * fq;
#pragma unroll
            for (int ai = 0; ai < 2; ++ai) { f32x4 c0[4], c1[4], s0[4], s1[4];
#pragma unroll
                for (int m = 0; m < 4; ++m) { const int pos = 16 + ((row0 + ai * HALF + m * 16) & 8191);
                    c0[m] = *(const f32x4*)(RC + pos * 32 + 8 * fq); c1[m] = *(const f32x4*)(RC + pos * 32 + 8 * fq + 4); s0[m] = *(const f32x4*)(RS + pos * 32 + 8 * fq); s1[m] = *(const f32x4*)(RS + pos * 32 + 8 * fq + 4); }
#pragma unroll
                for (int m = 0; m < 4; ++m) { const int row = row0 + ai * HALF + m * 16; const float rs = rl[ai * HALF + m * 16] * sc;
                    const f32x4 x1a = acc[ai][0][m][0] * rs, x1b = acc[ai][0][m][1] * rs, x2a = acc[ai][1][m][0] * rs, x2b = acc[ai][1][m][1] * rs;
                    store8(dst + (size_t)row * 512 + colb, x1a * c0[m] - x2a * s0[m], x1b * c1[m] - x2b * s1[m]);
                    store8(dst + (size_t)row * 512 + colb + 32, x2a * c0[m] + x1a * s0[m], x2b * c1[m] + x1b * s1[m]); }
                asm volatile("" ::: "memory"); }
        } else if (pn < 6) {
            const int col0 = (pn - 4) * BM + wc * 32 + 8 * fq;
#pragma unroll
            for (int ai = 0; ai < 2; ++ai)
#pragma unroll
                for (int m = 0; m < 4; ++m) { const int row = row0 + ai * HALF + m * 16; const float rs = rl[ai * HALF + m * 16];
                    store8(V + (size_t)row * 512 + col0, acc[ai][0][m][0] * rs, acc[ai][0][m][1] * rs); store8(V + (size_t)row * 512 + col0 + HALF, acc[ai][1][m][0] * rs, acc[ai][1][m][1] * rs); }
        } else {
            const int cc = (pn - 6) * HALF + wc * 32 + 8 * fq;
            const f32x4 ba0 = *(const f32x4*)(bglu + cc), ba1 = *(const f32x4*)(bglu + cc + 4), bg0 = *(const f32x4*)(bglu + 512 + cc), bg1 = *(const f32x4*)(bglu + 512 + cc + 4);
#pragma unroll
            for (int ai = 0; ai < 2; ++ai)
#pragma unroll
                for (int m = 0; m < 4; ++m) { const int row = row0 + ai * HALF + m * 16; const float rs = rl[ai * HALF + m * 16];
                    const f32x4 x0 = acc[ai][0][m][0] * rs + ba0, x1 = acc[ai][0][m][1] * rs + ba1, g0 = acc[ai][1][m][0] * rs + bg0, g1 = acc[ai][1][m][1] * rs + bg1;
                    store8(Z + (size_t)row * 512 + cc, x0 * sigmoid4(g0), x1 * sigmoid4(g1)); }
        }
    }
};
__device__ __forceinline__ f32x4 bf_lo4(const u32x4 w) { f32x4 r; r[0] = __builtin_bit_cast(float, w.x << 16); r[1] = __builtin_bit_cast(float, w.x & 0xffff0000u); r[2] = __builtin_bit_cast(float, w.y << 16); r[3] = __builtin_bit_cast(float, w.y & 0xffff0000u); return r; }
__device__ __forceinline__ f32x4 bf_hi4(const u32x4 w) { f32x4 r; r[0] = __builtin_bit_cast(float, w.z << 16); r[1] = __builtin_bit_cast(float, w.z & 0xffff0000u); r[2] = __builtin_bit_cast(float, w.w << 16); r[3] = __builtin_bit_cast(float, w.w & 0xffff0000u); return r; }
struct EpiResid {
    static constexpr bool PERM = true, AFTER_DRAIN = false;
    bf16_t* HB; float* SS;
    __device__ __forceinline__ void rg(const f32x4 a00, const f32x4 a01, const f32x4 a10, const f32x4 a11, int row, int pn, int wc, int fq) const {
        const int col0 = pn * BM + wc * 32 + 8 * fq; const bf16_t* hp = HB + (size_t)row * 1024 + col0;
        rgw(a00, a01, a10, a11, row, pn, wc, fq, *(const u32x4*)(hp), *(const u32x4*)(hp + HALF));
    }
    __device__ __forceinline__ void rgw(const f32x4 a00, const f32x4 a01, const f32x4 a10, const f32x4 a11, int row, int pn, int wc, int fq, const u32x4 w0, const u32x4 w1) const {
        const int col0 = pn * BM + wc * 32 + 8 * fq; bf16_t* hp = HB + (size_t)row * 1024 + col0;
        const f32x4 h0 = bf_lo4(w0) + a00, h1 = bf_hi4(w0) + a01, h2 = bf_lo4(w1) + a10, h3 = bf_hi4(w1) + a11;
        float ssq = (((h0[0] * h0[0] + h0[1] * h0[1]) + (h0[2] * h0[2] + h0[3] * h0[3])) + ((h1[0] * h1[0] + h1[1] * h1[1]) + (h1[2] * h1[2] + h1[3] * h1[3])))
                  + (((h2[0] * h2[0] + h2[1] * h2[1]) + (h2[2] * h2[2] + h2[3] * h2[3])) + ((h3[0] * h3[0] + h3[1] * h3[1]) + (h3[2] * h3[2] + h3[3] * h3[3])));
        store8(hp, h0, h1); store8(hp + HALF, h2, h3);
        ssq += __shfl_xor(ssq, 16); ssq += __shfl_xor(ssq, 32);
        if (fq == 0) SS[(size_t)row * 16 + pn * 4 + wc] = ssq;
    }
    __device__ __forceinline__ void operator()(const f32x4 (&acc)[2][2][4][2], const Unit& u, int wr, int wc, int fr, int fq, int) const {
        const int row0 = u.pm * BM + wr * 64 + fr; const int col0 = u.pn * BM + wc * 32 + 8 * fq;
        u32x4 w[2][2][2];
#define PG8_RES_LOAD(slot, b) do { _Pragma("unroll") for (int m2 = 0; m2 < 2; ++m2) { const int g_ = 2 * (b) + m2; \
            const bf16_t* hp = HB + (size_t)(row0 + (g_ >> 2) * HALF + (g_ & 3) * 16) * 1024 + col0; w[slot][m2][0] = *(const u32x4*)(hp); w[slot][m2][1] = *(const u32x4*)(hp + HALF); } } while (0)
        PG8_RES_LOAD(0, 0);
#pragma unroll
        for (int b = 0; b < 4; ++b) {
            if (b + 1 < 4) { if (((b + 1) & 1) == 0) PG8_RES_LOAD(0, b + 1); else PG8_RES_LOAD(1, b + 1); }
#pragma unroll
            for (int m2 = 0; m2 < 2; ++m2) { const int g_ = 2 * b + m2, ai = g_ >> 2, m = g_ & 3;
                rgw(acc[ai][0][m][0], acc[ai][0][m][1], acc[ai][1][m][0], acc[ai][1][m][1], row0 + ai * HALF + m * 16, u.pn, wc, fq, w[b & 1][m2][0], w[b & 1][m2][1]); }
            asm volatile("" ::: "memory");
        }
#undef PG8_RES_LOAD
    }
};
struct EpiSwiGLU {
    static constexpr bool PERM = true, AFTER_DRAIN = false;
    bf16_t* ACT; const float* SS; const PG8_LAS float* RL;
    __device__ __forceinline__ void rg(const f32x4 a00, const f32x4 a01, const f32x4 a10, const f32x4 a11, int row, int pn, int wc, int fq) const { rgs(a00, a01, a10, a11, row, pn, wc, fq, row_rstd(SS, row)); }
    __device__ __forceinline__ void rgs(const f32x4 a00, const f32x4 a01, const f32x4 a10, const f32x4 a11, int row, int pn, int wc, int fq, const float rs) const {
        const int col0 = pn * HALF + wc * 32 + 8 * fq;
        const f32x4 g0 = a00 * rs, g1 = a01 * rs, u0 = a10 * rs, u1 = a11 * rs;
        store8(ACT + (size_t)row * 2816 + col0, g0 * sigmoid4(g0) * u0, g1 * sigmoid4(g1) * u1);
    }
    PG8_EPI_LOOP_RS()
};
template <class Epi, class Sched, bool ALIGN_EPI = false, bool SP2 = false>
__device__ __forceinline__ void gemm_phase(PG8_LAS unsigned char* lds, const Gemm g, const Sched& S, const Epi& E) {
    int tid_ = threadIdx.x; asm volatile("" : "+v"(tid_));
    const int tid = tid_, wid = __builtin_amdgcn_readfirstlane(tid >> 6), lane = tid & 63, wr = wid >> 2, wc = wid & 3, fr = lane & 15, fq = lane >> 4;
    const int K = g.K, nt = K / BK;
    unsigned voffA[2], voffB[2];
#pragma unroll
    for (int i = 0; i < 2; ++i) { int R, C; stage_rc(tid * 16 + i * 8192, R, C); const int Rb = Epi::PERM ? ((R & ~31) + perm32(R & 31)) : R;
        voffA[i] = (unsigned)(R * K + C) * 2u; voffB[i] = (unsigned)(Rb * K + C) * 2u; }
    const size_t kstep = (size_t)(BK * 2);
    const size_t hstep = (size_t)HALF * K * 2;
    const size_t tstep = 2 * hstep;
    const unsigned ldsw = (unsigned)wid * 1024u;
    const int aoff = lds_byte(wr * 64 + fr, fq * 8), boff = lds_byte(wc * 32 + fr, fq * 8);
#define PG8_SA(b, h) (((b) * 2 + (h)) * HTB)
#define PG8_SB(b, h) ((4 + (b) * 2 + (h)) * HTB)
#define PG8_STAGE(bufoff, gbase, voff) do { _Pragma("unroll") for (int _i = 0; _i < 2; ++_i) \
        __builtin_amdgcn_global_load_lds((const unsigned*)((const char*)(gbase) + (voff)[_i]), (PG8_LAS unsigned*)(lds + (bufoff) + ldsw + _i * 8192), 16, 0, 0); } while (0)
#define PG8_LDA(dst, b, h) do { _Pragma("unroll") for (int m = 0; m < 4; ++m) _Pragma("unroll") for (int k = 0; k < 2; ++k) dst[m][k] = *(const PG8_LAS bf16x8*)(lds + PG8_SA(b, h) + aoff + m * 2048 + k * 1024); } while (0)
#define PG8_LDB(dst, b, h) do { _Pragma("unroll") for (int n = 0; n < 2; ++n) _Pragma("unroll") for (int k = 0; k < 2; ++k) dst[n][k] = *(const PG8_LAS bf16x8*)(lds + PG8_SB(b, h) + boff + n * 2048 + k * 1024); } while (0)
#define PG8_MMA(ai, bj, At, Bt) do { __builtin_amdgcn_s_setprio(1); _Pragma("unroll") for (int m = 0; m < 4; ++m) _Pragma("unroll") for (int n = 0; n < 2; ++n) _Pragma("unroll") for (int k = 0; k < 2; ++k) \
        acc[ai][bj][m][n] = __builtin_amdgcn_mfma_f32_16x16x32_bf16(Bt[n][k], At[m][k], acc[ai][bj][m][n], 0, 0, 0); __builtin_amdgcn_s_setprio(0); } while (0)
#define PG8_WAIT_V(n) asm volatile("s_waitcnt vmcnt(" #n ")" ::: "memory")
#define PG8_WAIT_L(n) asm volatile("s_waitcnt lgkmcnt(" #n ")" ::: "memory")
#define PG8_BAR __builtin_amdgcn_s_barrier()
#define PG8_SCHED __builtin_amdgcn_sched_barrier(0)
    Unit cur, nxt; int ui = 0;
    if (!S.next(0, cur)) return;
    f32x4 acc[2][2][4][2];
#pragma unroll
    for (int a = 0; a < 2; ++a)
#pragma unroll
        for (int b = 0; b < 2; ++b)
#pragma unroll
            for (int m = 0; m < 4; ++m)
#pragma unroll
                for (int n = 0; n < 2; ++n) acc[a][b][m][n] = (f32x4){0.f, 0.f, 0.f, 0.f};
    bf16x8 At[4][2], B0[2][2], B1[2][2];
    const char* cA = (const char*)g.A + (size_t)cur.pm * tstep; const char* cB = (const char*)g.Bt + (size_t)cur.pn * tstep;
    S.a_ready(cur);
    if constexpr (SP2) {
        PG8_STAGE(PG8_SB(0, 0), cB, voffB); PG8_STAGE(PG8_SB(0, 1), cB + hstep, voffB); PG8_STAGE(PG8_SA(0, 0), cA, voffA); PG8_STAGE(PG8_SA(0, 1), cA + hstep, voffA);
        if (wr == 1) PG8_BAR;
        PG8_WAIT_V(2); PG8_BAR;
        PG8_STAGE(PG8_SB(1, 0), cB + kstep, voffB); PG8_STAGE(PG8_SA(1, 0), cA + kstep, voffA); PG8_STAGE(PG8_SB(1, 1), cB + hstep + kstep, voffB);
        PG8_WAIT_V(6); PG8_BAR;
    } else {
        PG8_STAGE(PG8_SB(0, 0), cB, voffB); PG8_STAGE(PG8_SA(0, 0), cA, voffA); PG8_STAGE(PG8_SB(0, 1), cB + hstep, voffB); PG8_STAGE(PG8_SA(0, 1), cA + hstep, voffA);
        if (wr == 1) PG8_BAR;
        PG8_WAIT_V(4); PG8_BAR;
        PG8_STAGE(PG8_SB(1, 0), cB + kstep, voffB); PG8_STAGE(PG8_SA(1, 0), cA + kstep, voffA); PG8_STAGE(PG8_SB(1, 1), cB + hstep + kstep, voffB);
        PG8_WAIT_V(6); PG8_BAR;
    }
    for (;;) {
        const bool has_next = S.next(ui + 1, nxt);
        const char* nA = has_next ? (const char*)g.A + (size_t)nxt.pm * tstep : cA; const char* nB = has_next ? (const char*)g.Bt + (size_t)nxt.pn * tstep : cB;
        for (int t = 0; t < nt; t += 2) {
            const bool last = (t == nt - 2);
            const char* a1 = cA + (size_t)(t + 1) * kstep;
            const char* a2 = last ? nA : cA + (size_t)(t + 2) * kstep; const char* b2 = last ? nB : cB + (size_t)(t + 2) * kstep;
            const char* a3 = a2 + kstep; const char* b3 = b2 + kstep;
            if (last && has_next) S.a_ready(nxt);
            if constexpr (SP2) {
            PG8_LDB(B0, 0, 0); PG8_LDB(B1, 0, 1); PG8_SCHED; PG8_LDA(At, 0, 0); PG8_STAGE(PG8_SA(1, 1), a1 + hstep, voffA);
            PG8_WAIT_V(8); PG8_WAIT_L(0); PG8_BAR; PG8_MMA(0, 0, At, B0); PG8_MMA(0, 1, At, B1); PG8_BAR; PG8_SCHED;
            PG8_LDA(At, 0, 1); PG8_STAGE(PG8_SB(0, 0), b2, voffB); PG8_STAGE(PG8_SB(0, 1), b2 + hstep, voffB); PG8_STAGE(PG8_SA(0, 0), a2, voffA);
            PG8_WAIT_V(8); PG8_WAIT_L(0); PG8_BAR; PG8_MMA(1, 0, At, B0); PG8_MMA(1, 1, At, B1); PG8_BAR; PG8_SCHED;
            PG8_LDB(B0, 1, 0); PG8_LDB(B1, 1, 1); PG8_SCHED; PG8_LDA(At, 1, 0); PG8_STAGE(PG8_SA(0, 1), a2 + hstep, voffA);
            PG8_WAIT_V(8); PG8_WAIT_L(0); PG8_BAR; PG8_MMA(0, 0, At, B0); PG8_MMA(0, 1, At, B1); PG8_BAR; PG8_SCHED;
            PG8_LDA(At, 1, 1); PG8_STAGE(PG8_SB(1, 0), b3, voffB); PG8_STAGE(PG8_SB(1, 1), b3 + hstep, voffB); PG8_STAGE(PG8_SA(1, 0), a3, voffA);
            PG8_WAIT_V(8); PG8_WAIT_L(0); PG8_BAR; PG8_MMA(1, 0, At, B0); PG8_MMA(1, 1, At, B1); PG8_BAR; PG8_SCHED;
            } else {
            PG8_LDB(B0, 0, 0); PG8_SCHED; PG8_LDA(At, 0, 0); PG8_STAGE(PG8_SA(1, 1), a1 + hstep, voffA);
            PG8_WAIT_L(8); PG8_BAR; PG8_WAIT_L(0); PG8_MMA(0, 0, At, B0); PG8_BAR; PG8_SCHED;
            PG8_LDB(B1, 0, 1); PG8_STAGE(PG8_SB(0, 0), b2, voffB);
            PG8_BAR; PG8_WAIT_L(0); PG8_MMA(0, 1, At, B1); PG8_BAR;
            PG8_LDA(At, 0, 1); PG8_STAGE(PG8_SA(0, 0), a2, voffA);
            PG8_BAR; PG8_WAIT_L(0); PG8_MMA(1, 0, At, B0); PG8_BAR; PG8_SCHED;
            PG8_STAGE(PG8_SB(0, 1), b2 + hstep, voffB);
            PG8_WAIT_V(6); PG8_BAR; PG8_MMA(1, 1, At, B1); PG8_BAR;
            PG8_LDB(B0, 1, 0); PG8_SCHED; PG8_LDA(At, 1, 0); PG8_STAGE(PG8_SA(0, 1), a2 + hstep, voffA);
            PG8_WAIT_L(8); PG8_BAR; PG8_WAIT_L(0); PG8_MMA(0, 0, At, B0); PG8_BAR; PG8_SCHED;
            PG8_LDB(B1, 1, 1); PG8_STAGE(PG8_SB(1, 0), b3, voffB);
            PG8_BAR; PG8_WAIT_L(0); PG8_MMA(0, 1, At, B1); PG8_BAR;
            PG8_LDA(At, 1, 1); PG8_STAGE(PG8_SA(1, 0), a3, voffA);
            PG8_BAR; PG8_WAIT_L(0); PG8_MMA(1, 0, At, B0); PG8_BAR; PG8_SCHED;
            PG8_STAGE(PG8_SB(1, 1), b3 + hstep, voffB);
            PG8_WAIT_V(6); PG8_BAR; PG8_MMA(1, 1, At, B1); PG8_BAR;
            }
        }
        if constexpr (ALIGN_EPI) { if (wr == 0) PG8_BAR; }
        if constexpr (!Epi::AFTER_DRAIN) { E(acc, cur, wr, wc, fr, fq, ui); S.done(cur); }
        if (!has_next) break;
#pragma unroll
        for (int a = 0; a < 2; ++a)
#pragma unroll
            for (int b = 0; b < 2; ++b)
#pragma unroll
                for (int m = 0; m < 4; ++m)
#pragma unroll
                    for (int n = 0; n < 2; ++n) acc[a][b][m][n] = (f32x4){0.f, 0.f, 0.f, 0.f};
        cur = nxt; cA = nA; cB = nB; ++ui;
        if constexpr (ALIGN_EPI) { if (wr == 1) PG8_BAR; }
    }
    PG8_WAIT_V(0);
    if constexpr (!ALIGN_EPI) { if (wr == 0) PG8_BAR; }
    PG8_BAR;
    if constexpr (Epi::AFTER_DRAIN) { E.fused(acc, cur, wr, wc, fr, fq, lds, wid, lane); S.done(cur); }
#undef PG8_SA
#undef PG8_SB
#undef PG8_STAGE
#undef PG8_LDA
#undef PG8_LDB
#undef PG8_MMA
#undef PG8_WAIT_V
#undef PG8_WAIT_L
#undef PG8_BAR
#undef PG8_SCHED
}
}
#include <hip/hip_bf16.h>
#include <cmath>
namespace attn_body {
using bf16=__hip_bfloat16;
using bf16x8=__attribute__((ext_vector_type(8)))short;
using s16x4=__attribute__((ext_vector_type(4)))short;
using f32x16=__attribute__((ext_vector_type(16)))float;
using u32x4=__attribute__((ext_vector_type(4)))unsigned;
constexpr int SEQ=8192,D=64,PQ=512,PK=512,PV=512,PO=1024,METAROW=32768;
constexpr int NW=8,QBLK=32,QB=QBLK*NW,KVBLK=64,NQB=SEQ/QB;
constexpr int ATTN_UNIT_ROWS=QB;
__device__ __forceinline__ int crow(int r,int hi){return (r&3)+8*(r>>2)+4*hi;}
#define SBAR() __builtin_amdgcn_sched_barrier(0)
__device__ __forceinline__ void cmask(f32x16&p0,f32x16&p1,int jb,int qrel,int hi){
  const float NEG=-INFINITY; int kb=64*jb+4*hi;
  #pragma unroll
  for(int r=0;r<16;++r){int kv=kb+(r&3)+8*(r>>2); if(kv>qrel)p0[r]=NEG; if(kv+32>qrel)p1[r]=NEG;}
}

constexpr int NSLOT=3, SLOTB=8192, VSLOTB=2*SLOTB;
constexpr int LDS_K=0, LDS_V=NSLOT*SLOTB, LDS_WS=LDS_V+NSLOT*VSLOTB, LDS_OST=LDS_WS+NW*64*4, LDS_QS=LDS_OST+NW*4096, LDS_BYTES=LDS_QS+NW*4096;
constexpr float C2=0.125f*1.4426950408889634f;
__device__ __forceinline__ void glds16(const void*sbase,unsigned voff,unsigned lds_dst){unsigned keep;
  asm volatile("s_mov_b32 %0, m0\n\ts_mov_b32 m0, %3\n\ts_nop 0\n\tglobal_load_lds_dwordx4 %1, %2\n\ts_mov_b32 m0, %0":"=&s"(keep):"v"(voff),"s"(sbase),"s"(lds_dst):"memory");}
template<int IMM> __device__ __forceinline__ void glds16o(const void*sbase,unsigned voff,unsigned lds_dst){unsigned keep;
  asm volatile("s_mov_b32 %0, m0\n\ts_mov_b32 m0, %3\n\ts_nop 0\n\tglobal_load_lds_dwordx4 %1, %2 offset:%c4\n\ts_mov_b32 m0, %0":"=&s"(keep):"v"(voff),"s"(sbase),"s"(lds_dst),"i"(IMM):"memory");}
__device__ __forceinline__ float max3f(float a,float b,float c){float r;asm("v_max3_f32 %0, %1, %2, %3":"=v"(r):"v"(a),"v"(b),"v"(c));return r;}
__device__ __forceinline__ float max2f(float a,float b){float r;asm("v_max_f32_e32 %0, %1, %2":"=v"(r):"v"(a),"v"(b));return r;}
__device__ __forceinline__ float fadd_s(float a,float b){float r;asm("v_add_f32_e32 %0, %1, %2":"=v"(r):"v"(a),"v"(b));return r;}
__device__ __forceinline__ float fsub_s(float a,float b){float r;asm("v_sub_f32_e32 %0, %1, %2":"=v"(r):"v"(a),"v"(b));return r;}
typedef float f32x2_t __attribute__((ext_vector_type(2))); typedef __bf16 bf16x2_t __attribute__((ext_vector_type(2)));
__device__ __forceinline__ unsigned cvtpk_s(float lo,float hi){f32x2_t v={lo,hi};bf16x2_t b=__builtin_convertvector(v,bf16x2_t);return __builtin_bit_cast(unsigned,b);}
#define WAIT_BAR(N) asm volatile("s_waitcnt vmcnt(" #N ") lgkmcnt(0)\n\ts_barrier":::"memory")

typedef __attribute__((address_space(3))) const char* lds_cptr;
__device__ __forceinline__ void qkt(f32x16&p0,f32x16&p1,const char*Kslot,lds_cptr qsp,int r32,int hi){
  const char*kb=Kslot+hi*1024+r32*16; const f32x16 z=f32x16{};
  #pragma unroll
  for(int d0=0;d0<4;++d0){
    const bf16x8 b0=*reinterpret_cast<const bf16x8*>(kb+d0*2048);
    const bf16x8 b1=*reinterpret_cast<const bf16x8*>(kb+d0*2048+512);
    const bf16x8 q=*(const __attribute__((address_space(3))) bf16x8*)(qsp+d0*1024);
    if(d0==0){p0=__builtin_amdgcn_mfma_f32_32x32x16_bf16(b0,q,z,0,0,0);p1=__builtin_amdgcn_mfma_f32_32x32x16_bf16(b1,q,z,0,0,0);}
    else{p0=__builtin_amdgcn_mfma_f32_32x32x16_bf16(b0,q,p0,0,0,0);p1=__builtin_amdgcn_mfma_f32_32x32x16_bf16(b1,q,p1,0,0,0);}}
}
typedef short v4i16_t __attribute__((ext_vector_type(4)));
__device__ __forceinline__ void kload8(bf16x8*kf,lds_cptr kp){
  kf[0]=*(const __attribute__((address_space(3))) bf16x8*)(kp);      kf[1]=*(const __attribute__((address_space(3))) bf16x8*)(kp+512);
  kf[2]=*(const __attribute__((address_space(3))) bf16x8*)(kp+2048); kf[3]=*(const __attribute__((address_space(3))) bf16x8*)(kp+2560);
  kf[4]=*(const __attribute__((address_space(3))) bf16x8*)(kp+4096); kf[5]=*(const __attribute__((address_space(3))) bf16x8*)(kp+4608);
  kf[6]=*(const __attribute__((address_space(3))) bf16x8*)(kp+6144); kf[7]=*(const __attribute__((address_space(3))) bf16x8*)(kp+6656);
}
__device__ __forceinline__ void kload2(bf16x8*kf,lds_cptr kp,int j){ kf[2*j]=*(const __attribute__((address_space(3))) bf16x8*)(kp+j*2048); kf[2*j+1]=*(const __attribute__((address_space(3))) bf16x8*)(kp+j*2048+512); }
__device__ __forceinline__ s16x4 vtr(lds_cptr p){ return __builtin_bit_cast(s16x4,__builtin_amdgcn_ds_read_tr16_b64_v4i16((__attribute__((address_space(3))) v4i16_t*)p)); }
__device__ __forceinline__ float rowmax(const f32x16&p0,const f32x16&p1){
  float a=max3f(p0[0],p0[1],p1[0]),b=max3f(p0[2],p0[3],p1[1]);a=max3f(a,p1[2],p1[3]);
  #pragma unroll
  for(int r=4;r<16;r+=4){a=max3f(a,p0[r],p0[r+1]);b=max3f(b,p0[r+2],p0[r+3]);a=max3f(a,p1[r],p1[r+1]);b=max3f(b,p1[r+2],p1[r+3]);}
  const float m=max2f(a,b);
  auto rr=__builtin_amdgcn_permlane32_swap(__float_as_uint(m),__float_as_uint(m),false,false);
  return max2f(__uint_as_float(rr[0]),__uint_as_float(rr[1]));
}
__device__ __forceinline__ void pv(f32x16*o,int vb,bf16x8 pa0,bf16x8 pa1,bf16x8 pa2,bf16x8 pa3){
  #pragma unroll
  for(int d0=0;d0<4;++d0){s16x4 lo[4],hi[4];
    #pragma unroll
    for(int ks=0;ks<4;++ks){
      asm volatile("ds_read_b64_tr_b16 %0,%1 offset:%c2":"=&v"(lo[ks]):"v"(vb),"i"(d0*4096+ks*1024):"memory");
      asm volatile("ds_read_b64_tr_b16 %0,%1 offset:%c2":"=&v"(hi[ks]):"v"(vb),"i"(d0*4096+ks*1024+512):"memory");}
    asm volatile("s_waitcnt lgkmcnt(0)":::"memory");SBAR();
    #define PK(k) (bf16x8){lo[k][0],lo[k][1],lo[k][2],lo[k][3],hi[k][0],hi[k][1],hi[k][2],hi[k][3]}
    o[d0]=__builtin_amdgcn_mfma_f32_32x32x16_bf16(pa0,PK(0),o[d0],0,0,0);
    o[d0]=__builtin_amdgcn_mfma_f32_32x32x16_bf16(pa1,PK(1),o[d0],0,0,0);
    o[d0]=__builtin_amdgcn_mfma_f32_32x32x16_bf16(pa2,PK(2),o[d0],0,0,0);
    o[d0]=__builtin_amdgcn_mfma_f32_32x32x16_bf16(pa3,PK(3),o[d0],0,0,0);
    #undef PK
  }
}

#ifndef ATTN_STORE16
#define ATTN_STORE16(p,v) (*(u32x4*)(p)=(v))
#endif
template<int THRL> __device__ __forceinline__ void attn_unit(int b,int vh,int qb,int nqb,bool pre,const bf16*Q,const bf16*__restrict__ K,const bf16*__restrict__ V,bf16*O,char*shm){
  int tid_=threadIdx.x; asm volatile("":"+v"(tid_)); const int tid=tid_,lane=tid&63,r32=lane&31,hi=lane>>5; const int wid=__builtin_amdgcn_readfirstlane(tid>>6);
  const int qcol=vh*64, vcol=(vh>>1)*128, ocol=vh*128;
  const long rowbase=(long)b*SEQ; const int q0=qb*QB;
  const bf16*Qw=Q+(rowbase+q0+wid*QBLK)*PQ+qcol;
  const unsigned lds0=(unsigned)(uintptr_t)shm;
  float*wsf=(float*)(shm+LDS_WS)+wid*64;
  const unsigned koff=(unsigned)((lane*PK+wid*8+qcol)*2), voff=(unsigned)(((16*(wid&3)+(lane>>2))*PV+(wid>>2)*32+(lane&3)*8+vcol)*2);
  const bf16*ksrc=K+(rowbase-KVBLK)*PK, *kmeta=K+(long)METAROW*PK;
  const bf16*vsrc=V+(rowbase-KVBLK)*PV, *vmeta=V+(long)METAROW*PV;
  const unsigned kdst=lds0+LDS_K+wid*1024, vdst=lds0+LDS_V+wid*1024;
  #define DMA_K(t,slot) glds16(((t)==0?kmeta:ksrc+(long)(t)*KVBLK*PK),koff,(unsigned)__builtin_amdgcn_readfirstlane(kdst+(slot)))
  #define DMA_V(t,slot) do{ const bf16*vs_=((t)==0?vmeta:vsrc+(long)(t)*KVBLK*PV); const unsigned vd_=(unsigned)__builtin_amdgcn_readfirstlane(vdst+2*(slot)); glds16(vs_,voff,vd_); glds16(vs_,voff+128u,vd_+8192); }while(0)
  const int vb0=(int)(lds0+LDS_V)+((lane>>4)&1)*32+(lane&3)*8+(4*hi+((lane&15)>>2))*64;
  const char*Kbase=shm+LDS_K; bf16x8 kf[8];
  const lds_cptr shm3=(lds_cptr)shm; const lds_cptr kp0=shm3+LDS_K+hi*1024+r32*16; const lds_cptr vp0=shm3+LDS_V+((lane>>4)&1)*32+(lane&3)*8+(4*hi+((lane&15)>>2))*64;
  const int NT=(q0+QB)/KVBLK+1;
  if(!pre){ DMA_K(0,0);DMA_V(0,0);DMA_K(1,SLOTB); }
  const lds_cptr qsp=shm3+LDS_QS+wid*4096+lane*16;
  if(!pre){ bf16x8 qt[4];
    #pragma unroll
    for(int d0=0;d0<4;++d0)qt[d0]=*reinterpret_cast<const bf16x8*>(&Qw[(long)r32*PQ+d0*16+hi*8]);
    #pragma unroll
    for(int d0=0;d0<4;++d0)*(__attribute__((address_space(3))) bf16x8*)(shm3+LDS_QS+wid*4096+lane*16+d0*1024)=qt[d0]; }
  float mhat=0.f,l_reg=0.f;f32x16 o[4];o[0]=f32x16{};o[1]=f32x16{};o[2]=f32x16{};o[3]=f32x16{};f32x16 negm=f32x16{};asm volatile("":"+v"(negm));
  const int qrel=wid*QBLK+r32;
  #define CMASK(P0,P1,t) do{int jb_=(t)-(NT-4); if(jb_>=0)cmask(P0,P1,jb_,qrel,hi);}while(0)
  bool resc=false;
  #define START(P0,P1) do{ const float rm=rowmax(P0,P1); resc=false; \
    { const float dl=rm; mhat=fadd_s(mhat,dl); \
      _Pragma("unroll") for(int r=0;r<16;++r){P0[r]=fsub_s(P0[r],dl);P1[r]=fsub_s(P1[r],dl);} \
      _Pragma("unroll") for(int r=0;r<16;++r)negm[r]=-mhat; asm volatile("":"+v"(negm)); } \
    _Pragma("unroll") for(int r=0;r<16;++r)P0[r]=__builtin_amdgcn_exp2f(P0[r]); }while(0)
  #define RESC() do{ if(resc){ asm volatile("s_waitcnt lgkmcnt(0)":::"memory"); \
      _Pragma("unroll") for(int d_=0;d_<4;++d_) _Pragma("unroll") for(int r=0;r<16;++r)o[d_][r]*=wsf[crow(r,hi)]; } }while(0)
  f32x16 pA0,pA1,pB0,pB1;
  int sl_prev=0,sl_cur=0,sl_next=SLOTB;
  #define ROT() do{sl_prev=sl_cur;sl_cur=sl_next;sl_next=(sl_next==(NSLOT-1)*SLOTB)?0:sl_next+SLOTB;}while(0)
  DMA_K(2,2*SLOTB);
  if(pre){ asm volatile("s_waitcnt lgkmcnt(0)\n\ts_barrier":::"memory"); }
  else { WAIT_BAR(4); }
  qkt(pB0,pB1,Kbase,qsp,r32,hi);asm volatile("s_nop 15\n\ts_nop 7":"+v"(pB0),"+v"(pB1));
  { _Pragma("unroll") for(int r_=0;r_<16;++r_){ if(r_>=8)pB0[r_]=-INFINITY; pB1[r_]=-INFINITY; } }
  START(pB0,pB1);
  _Pragma("unroll") for(int r=0;r<16;++r)pB1[r]=__builtin_amdgcn_exp2f(pB1[r]);
  WAIT_BAR(0);
  DMA_K(3,0);DMA_V(1,SLOTB);
  ROT();
  kload8(kf,kp0+sl_cur);
  WAIT_BAR(3);
  s16x4 vlo[8],vhi[8]; u32x4 pw0,pw1,pw2,pw3;
  #define PKW(P,B) cvtpk_s(P[B],P[B+1])
  #define PAF(k) __builtin_bit_cast(bf16x8,pw##k)
  #define VFR(i) (bf16x8){vlo[i][0],vlo[i][1],vlo[i][2],vlo[i][3],vhi[i][0],vhi[i][1],vhi[i][2],vhi[i][3]}
  #define PIN(x) asm volatile("":"+v"(x))
  #define MX3(a,b,c) __builtin_fmaxf(__builtin_fmaxf((a),(b)),(c))
  #define GAPA(MF,A0,A1,A2,A3,W0,W1,PW) do{ MF; sacc+=A0; sacc+=A1; sacc+=A2; sacc+=A3; PIN(sacc); W0; W1; PIN(PW); SBAR(); }while(0)
  #define EX(v) __builtin_amdgcn_exp2f(v)
  #define GAPB2(MF,X,B) do{ MF; X[B]=EX(X[B]); X[B+1]=EX(X[B+1]); PIN(X); SBAR(); }while(0)
  #define VRD(i) do{ vlo[i]=vtr(vp_+(((i)>>2)*4096+((i)&3)*1024)); vhi[i]=vtr(vp_+(((i)>>2)*4096+((i)&3)*1024+512)); }while(0)
  #define VRD2(i) do{ vlo[i]=vtr(vp_+((((i)>>2)+2)*4096+((i)&3)*1024)); vhi[i]=vtr(vp_+((((i)>>2)+2)*4096+((i)&3)*1024+512)); }while(0)
  #define KRD(G,j) do{ if(G){ kload2(kf,kp0+sl_next,j); SBAR(); } }while(0)
  #define QL(d) (*(const __attribute__((address_space(3))) bf16x8*)(qsp+(d)*1024))
  #define MF32(a,b,c) __builtin_amdgcn_mfma_f32_32x32x16_bf16(a,b,c,0,0,0)
  #define STEP(C0,C1,P0,P1,t,GK,GV,GL) do{ SBAR(); \
    const lds_cptr vp_=vp0+2*sl_prev; \
    const bf16x8 q0_=QL(0), q1_=QL(1); \
    VRD(0); SBAR(); float sacc=(P0[0]+P0[1]); \
    GAPA(C0=MF32(kf[0],q0_,negm), P0[2],P0[3],P0[4],P0[5],     pw0[0]=PKW(P0,0), pw0[1]=PKW(P0,2), pw0); \
    VRD(4); SBAR(); GAPA(C1=MF32(kf[1],q0_,negm), P0[6],P0[7],P0[8],P0[9],     pw0[2]=PKW(P0,4), pw0[3]=PKW(P0,6), pw0); \
    const bf16x8 q2_=QL(2); \
    VRD(1); SBAR(); GAPA(C0=MF32(kf[2],q1_,C0),   P0[10],P0[11],P0[12],P0[13], pw1[0]=PKW(P0,8), pw1[1]=PKW(P0,10), pw1); \
    VRD(5); SBAR(); GAPA(C1=MF32(kf[3],q1_,C1),   P0[14],P0[15],P1[0],P1[1],   pw1[2]=PKW(P0,12),pw1[3]=PKW(P0,14), pw1); \
    const bf16x8 q3_=QL(3); \
    VRD(2); SBAR(); GAPA(C0=MF32(kf[4],q2_,C0),   P1[2],P1[3],P1[4],P1[5],     pw2[0]=PKW(P1,0), pw2[1]=PKW(P1,2), pw2); \
    VRD(6); SBAR(); GAPA(C1=MF32(kf[5],q2_,C1),   P1[6],P1[7],P1[8],P1[9],     pw2[2]=PKW(P1,4), pw2[3]=PKW(P1,6), pw2); \
    VRD(3); SBAR(); GAPA(C0=MF32(kf[6],q3_,C0),   P1[10],P1[11],P1[12],P1[13], pw3[0]=PKW(P1,8), pw3[1]=PKW(P1,10), pw3); \
    VRD(7); SBAR(); GAPA(C1=MF32(kf[7],q3_,C1),   P1[14],P1[15],0.f,0.f,       pw3[2]=PKW(P1,12),pw3[3]=PKW(P1,14), pw3); \
    l_reg+=sacc; \
    if(GK){DMA_K((t)+3,sl_cur);} if(GV){DMA_V((t)+1,sl_next);} \
    CMASK(C0,C1,t); \
    { float a=MX3(C0[0],C0[1],C1[0]),b=MX3(C0[2],C0[3],C1[1]); a=MX3(a,C1[2],C1[3]); \
      _Pragma("unroll") for(int r=4;r<16;r+=4){a=MX3(a,C0[r],C0[r+1]);b=MX3(b,C0[r+2],C0[r+3]);a=MX3(a,C1[r],C1[r+1]);b=MX3(b,C1[r+2],C1[r+3]);} \
      float rm=__builtin_fmaxf(a,b); { auto rr=__builtin_amdgcn_permlane32_swap(__float_as_uint(rm),__float_as_uint(rm),false,false); rm=__builtin_fmaxf(__uint_as_float(rr[0]),__uint_as_float(rr[1])); } \
      resc=false; \
      if(__builtin_expect(__any(rm>(float)THRL),0)){ const float dl=__builtin_fmaxf(rm,0.f); mhat+=dl; \
        _Pragma("unroll") for(int r=0;r<16;++r){C0[r]-=dl;C1[r]-=dl;} \
        _Pragma("unroll") for(int r=0;r<16;++r)negm[r]=-mhat; asm volatile("":"+v"(negm)); \
        const float f=__builtin_amdgcn_exp2f(-dl); l_reg*=f; if(hi==0)wsf[r32]=f; resc=true; } } \
    SBAR(); \
    GAPB2(o[0]=MF32(PAF(0),VFR(0),o[0]), C0,0);  VRD2(0); SBAR(); \
    GAPB2(o[1]=MF32(PAF(0),VFR(4),o[1]), C0,2);  VRD2(4); SBAR(); \
    GAPB2(o[0]=MF32(PAF(1),VFR(1),o[0]), C0,4);  VRD2(1); SBAR(); \
    GAPB2(o[1]=MF32(PAF(1),VFR(5),o[1]), C0,6);  VRD2(5); SBAR(); \
    GAPB2(o[0]=MF32(PAF(2),VFR(2),o[0]), C0,8);  VRD2(2); SBAR(); \
    GAPB2(o[1]=MF32(PAF(2),VFR(6),o[1]), C0,10); VRD2(6); SBAR(); \
    GAPB2(o[0]=MF32(PAF(3),VFR(3),o[0]), C0,12); VRD2(3); SBAR(); \
    GAPB2(o[1]=MF32(PAF(3),VFR(7),o[1]), C0,14); VRD2(7); SBAR(); \
    GAPB2(o[2]=MF32(PAF(0),VFR(0),o[2]), C1,0); \
    GAPB2(o[3]=MF32(PAF(0),VFR(4),o[3]), C1,2); \
    KRD(GL,0); GAPB2(o[2]=MF32(PAF(1),VFR(1),o[2]), C1,4); \
    KRD(GL,1); GAPB2(o[3]=MF32(PAF(1),VFR(5),o[3]), C1,6); \
    KRD(GL,2); GAPB2(o[2]=MF32(PAF(2),VFR(2),o[2]), C1,8); \
    KRD(GL,3); GAPB2(o[3]=MF32(PAF(2),VFR(6),o[3]), C1,10); \
    GAPB2(o[2]=MF32(PAF(3),VFR(3),o[2]), C1,12); \
    GAPB2(o[3]=MF32(PAF(3),VFR(7),o[3]), C1,14); \
    }while(0)
  #define ENDW(tt) do{ if((tt)+3<NT){WAIT_BAR(3);} else if((tt)+2<NT){WAIT_BAR(2);} else {WAIT_BAR(0);} }while(0)
  STEP(pA0,pA1,pB0,pB1,1,(1+3<NT),true,true); ENDW(1); RESC(); ROT();
  int t=2;
  #undef CMASK
  #define CMASK(P0,P1,t) do{}while(0)
  for(;t+6<NT;t+=2){
    STEP(pB0,pB1,pA0,pA1,t,true,true,true);     WAIT_BAR(3); RESC(); ROT();
    STEP(pA0,pA1,pB0,pB1,t+1,true,true,true);   WAIT_BAR(3); RESC(); ROT();
  }
  #undef CMASK
  #define CMASK(P0,P1,t) do{int jb_=(t)-(NT-4); if(jb_>=0)cmask(P0,P1,jb_,qrel,hi);}while(0)
  for(;t+1<NT;t+=2){
    STEP(pB0,pB1,pA0,pA1,t,(t+3<NT),(t+1<NT),(t+1<NT));       ENDW(t);   RESC(); ROT();
    STEP(pA0,pA1,pB0,pB1,t+1,(t+4<NT),(t+2<NT),(t+2<NT));     ENDW(t+1); RESC(); ROT();
  }
  STEP(pB0,pB1,pA0,pA1,NT-1,false,false,false); RESC();
  { float sacc=pB0[0]+pB0[1]; _Pragma("unroll") for(int r=2;r<16;++r)sacc+=pB0[r]; _Pragma("unroll") for(int r=0;r<16;++r)sacc+=pB1[r]; l_reg+=sacc;
    pw0=(u32x4){PKW(pB0,0),PKW(pB0,2),PKW(pB0,4),PKW(pB0,6)};pw1=(u32x4){PKW(pB0,8),PKW(pB0,10),PKW(pB0,12),PKW(pB0,14)};pw2=(u32x4){PKW(pB1,0),PKW(pB1,2),PKW(pB1,4),PKW(pB1,6)};pw3=(u32x4){PKW(pB1,8),PKW(pB1,10),PKW(pB1,12),PKW(pB1,14)};
    SBAR(); pv(o,vb0+2*sl_cur,PAF(0),PAF(1),PAF(2),PAF(3)); }
  #undef PKW
  #undef PAF
  #undef VFR
  #undef PIN
  #undef MX3
  #undef GAPA
  #undef GAPB2
  #undef VRD2
  #undef QL
  #undef MF32
  #undef EX
  #undef VRD
  #undef KRD
  #undef STEP
  #undef ENDW
  bf16x8 qn[4];
  if(nqb>=0){ asm volatile("s_waitcnt lgkmcnt(0)\n\ts_barrier":::"memory");
    DMA_K(0,0);DMA_V(0,0);DMA_K(1,SLOTB);
    const bf16*Qn=Q+(rowbase+(long)nqb*QB+wid*QBLK)*PQ+qcol;
    #pragma unroll
    for(int d0=0;d0<4;++d0)qn[d0]=*reinterpret_cast<const bf16x8*>(&Qn[(long)r32*PQ+d0*16+hi*8]); }
  {auto rr=__builtin_amdgcn_permlane32_swap(__float_as_uint(l_reg),__float_as_uint(l_reg),false,false);l_reg=__uint_as_float(rr[0])+__uint_as_float(rr[1]);}
  if(hi==0)wsf[32+r32]=l_reg;asm volatile("s_waitcnt lgkmcnt(0)":::"memory");
  float rli[16];
  #pragma unroll
  for(int r=0;r<16;++r)rli[r]=__builtin_amdgcn_rcpf(wsf[32+crow(r,hi)]);
  bf16*Ow=O+(rowbase+q0+wid*QBLK)*PO+ocol;
  { bf16*stg=(bf16*)(shm+LDS_OST)+wid*2048;
    #pragma unroll
    for(int ps=0;ps<2;++ps){
    #pragma unroll
    for(int r=0;r<16;++r){const int orow=crow(r,hi);
      #pragma unroll
      for(int d0=0;d0<2;++d0)stg[orow*64+d0*32+r32]=__float2bfloat16(o[2*ps+d0][r]*rli[r]);}
    asm volatile("s_waitcnt lgkmcnt(0)":::"memory");
    #pragma unroll
    for(int i=0;i<4;++i){const int row=i*8+(lane>>3),ch=lane&7; const u32x4 v=*(const u32x4*)(stg+row*64+ch*8); ATTN_STORE16(Ow+(long)row*PO+ps*64+ch*8,v);}
    asm volatile("s_waitcnt lgkmcnt(0)":::"memory"); } }
  if(nqb>=0){
    #pragma unroll
    for(int d0=0;d0<4;++d0)*(__attribute__((address_space(3))) bf16x8*)(shm3+LDS_QS+wid*4096+lane*16+d0*1024)=qn[d0];
  } else { asm volatile("s_waitcnt lgkmcnt(0)\n\ts_barrier":::"memory"); }
  #undef DMA_K
  #undef DMA_V
  #undef CMASK
  #undef START
  #undef RESC
  #undef ROT
}
constexpr int ATTN_LDS_BYTES=LDS_BYTES;
struct AttnTensors { const bf16* Q; const bf16* K; const bf16* V; bf16* O; };
struct AttnUnit { int bvh; int qb; };
struct StaticOrder {
  int vcu;
  __device__ __forceinline__ explicit StaticOrder(int v):vcu(v){}
  __device__ __forceinline__ bool next(int i,AttnUnit&u)const{ if(i>=4)return false; const int s=vcu&7; u.bvh=vcu>>3; const int j=(i>>1)*8+s; u.qb=(i&1)?31-j:j; return true; }
};
template<class Sched,int THRL=8> __device__ __forceinline__ void attn_phase(char*lds,const AttnTensors&T,const Sched&S){
  AttnUnit u,un; bool pre=false; bool has=S.next(0,u);
  for(int i=0;has;++i){ const bool hn=S.next(i+1,un)&&un.bvh==u.bvh; attn_unit<THRL>(u.bvh>>3,u.bvh&7,u.qb,hn?un.qb:-1,pre,T.Q,T.K,T.V,T.O,lds); pre=hn; has=S.next(i+1,un); u=un; }
}
#undef SBAR
#undef WAIT_BAR
}
namespace cg = cooperative_groups;
constexpr int NWAVES = 8;
#ifndef MK_PER_PHASE
#define MK_PER_PHASE 0
#endif
#ifndef PROBE_DUP
#define PROBE_DUP -1
#endif
constexpr int NSLOT = (PROBE_DUP >= 0 && PROBE_DUP < 6) ? 7 : 6;
constexpr int NVPH = 2 + NSLOT * DEPTH;
constexpr int RING_BYTES = 131072, LDS_BYTES = 147456;

#define LAS __attribute__((address_space(3)))
typedef unsigned short bf16;
typedef unsigned v4u __attribute__((ext_vector_type(4)));
typedef unsigned v2u __attribute__((ext_vector_type(2)));
typedef float f32x4 __attribute__((ext_vector_type(4)));
typedef float f32x2 __attribute__((ext_vector_type(2)));
#define LDS_WAIT() asm volatile("s_waitcnt lgkmcnt(0)" ::: "memory")
#define LDS_BARRIER() asm volatile("s_waitcnt lgkmcnt(0)\n\ts_barrier" ::: "memory")
__device__ __forceinline__ unsigned f2bf(float f) { unsigned u = __builtin_bit_cast(unsigned, f); return (u + 0x7fffu + ((u >> 16) & 1u)) >> 16; }
__device__ __forceinline__ unsigned pk2(float lo, float hi) { return f2bf(lo) | (f2bf(hi) << 16); }
__device__ __forceinline__ float bflo(unsigned w) { return __builtin_bit_cast(float, w << 16); }
__device__ __forceinline__ float bfhi(unsigned w) { return __builtin_bit_cast(float, w & 0xffff0000u); }
__device__ __forceinline__ float bf1(bf16 h) { return __builtin_bit_cast(float, (unsigned)h << 16); }
#define DPP_ADD(v, ctrl, rowmask) v += __builtin_bit_cast(float, __builtin_amdgcn_update_dpp(0, __builtin_bit_cast(int, v), ctrl, rowmask, 0xF, false))
__device__ __forceinline__ float row16_sum(float v) {
    DPP_ADD(v, 0xB1, 0xF); DPP_ADD(v, 0x4E, 0xF); DPP_ADD(v, 0x141, 0xF); DPP_ADD(v, 0x140, 0xF); return v; }
__device__ __forceinline__ float wave_sum(float v) {
    v = row16_sum(v); DPP_ADD(v, 0x142, 0xA); DPP_ADD(v, 0x143, 0xC);
    return __builtin_bit_cast(float, __builtin_amdgcn_readlane(__builtin_bit_cast(int, v), 63)); }

struct Args { const float* in[19]; float* out; unsigned char* ws; int ph_lo, ph_hi; };

typedef const __attribute__((address_space(4))) Args* KArgs;
__device__ __forceinline__ KArgs kargs() { KArgs p = (KArgs)__builtin_amdgcn_kernarg_segment_ptr(); asm volatile("" : "+s"(p)); return p; }
enum { I_X = 0, I_META, I_NORM1G, I_WIN, I_BGLU, I_CONVW, I_CONVB, I_CLNG, I_CLNB, I_LQ1, I_LK1, I_LQ2, I_LK2, I_SUBG, I_WOUT, I_NORM2G, I_WGU, I_WDN, I_FINALG };
struct Frame {
    unsigned char* lds; int tid, lane, wave, vcu, G;
    unsigned char* ws;
};

__device__ __forceinline__ int featmap(int map, int n0) {
    const int pn = n0 >> 8, j = n0 & 255, bj = j >> 7, wc = (j & 127) >> 5;
    if (map == 1) { if (pn < 4) return (pn >> 1) * 512 + ((pn & 1) * 4 + wc) * 64 + bj * 32; if (pn < 6) return n0; return 1536 + bj * 512 + (pn - 6) * 128 + (j & 127); }
    if (map == 2) return bj * DFF + pn * 128 + (j & 127);
    return n0;
}
struct TrItem { const float* W; bf16* WT; const float* gain; int K, N, k0, n0, f0; };
__device__ __forceinline__ void tr_load(const TrItem& d, int lane, f32x4 (&v)[8], float (&gk)[8]) {
#pragma unroll
    for (int i = 0; i < 8; ++i) { const int kk = 8 * i + (lane >> 3); v[i] = *(const f32x4*)(d.W + (size_t)(d.k0 + kk) * d.N + d.f0 + 4 * (lane & 7)); gk[i] = d.gain ? d.gain[d.k0 + kk] : 1.0f; }
}
__device__ __forceinline__ void tr_store(const TrItem& d, int lane, const f32x4 (&v)[8], const float (&gk)[8], float* scr) {
#pragma unroll
    for (int i = 0; i < 8; ++i) { const int kk = 8 * i + (lane >> 3); float* p = scr + kk * 33 + 4 * (lane & 7); p[0] = v[i].x * gk[i]; p[1] = v[i].y * gk[i]; p[2] = v[i].z * gk[i]; p[3] = v[i].w * gk[i]; }
    LDS_WAIT(); asm volatile("" ::: "memory");
    const int c = lane & 7;
#pragma unroll
    for (int j = 0; j < 4; ++j) { const int n = (lane >> 3) + 8 * j; const float* s = scr + (8 * c) * 33 + n;
        v4u o; o.x = pk2(s[0 * 33], s[1 * 33]); o.y = pk2(s[2 * 33], s[3 * 33]); o.z = pk2(s[4 * 33], s[5 * 33]); o.w = pk2(s[6 * 33], s[7 * 33]);
        *(v4u*)(d.WT + (size_t)(d.n0 + n) * d.K + d.k0 + 8 * c) = o; }
    LDS_WAIT(); asm volatile("" ::: "memory");
}
__device__ __constant__ float ROPE_INV[32] = {1.f, 0.749894202f, 0.562341332f, 0.421696514f, 0.316227764f, 0.237137377f, 0.177827939f, 0.133352146f, 0.100000001f, 0.0749894232f, 0.0562341325f, 0.0421696492f,
    0.0316227749f, 0.0237137377f, 0.0177827943f, 0.013335214f, 0.00999999978f, 0.00749894232f, 0.00562341325f, 0.00421696482f, 0.00316227763f, 0.00237137382f, 0.00177827943f, 0.00133352145f, 0.00100000005f,
    0.000749894185f, 0.000562341302f, 0.000421696517f, 0.000316227757f, 0.00023713737f, 0.00017782794f, 0.00013335215f};

__device__ __forceinline__ void p0_prologue(Frame& F) {
    float* scr = (float*)(F.lds + F.wave * 16384);
    KArgs ka = kargs();
    const float *Fx = ka->in[I_X], *Fmeta = ka->in[I_META], *Fnorm1_g = ka->in[I_NORM1G], *Fw_in = ka->in[I_WIN], *Fw_out = ka->in[I_WOUT], *Fnorm2_g = ka->in[I_NORM2G], *Fw_gate_up = ka->in[I_WGU], *Fw_down = ka->in[I_WDN];
    const int gw = F.vcu * NWAVES + F.wave, NGW = F.G * NWAVES;
    constexpr int I_IN = (1024 / 64) * (NIN / 32), I_OUT = (1024 / 64) * (1024 / 32), I_GU = (1024 / 64) * (NGU / 32), I_DN = (DFF / 64) * (1024 / 32), I_L = I_IN + I_OUT + I_GU + I_DN;
    {
        auto decode = [&](int it) -> TrItem { TrItem d; const int l = it / I_L; int r = it % I_L; bf16* wl = (bf16*)(F.ws + OFF_W + (size_t)l * SZ_WL); int map;
            if (r < I_IN) { d.W = Fw_in + (size_t)l * 1024 * NIN; d.K = 1024; d.N = NIN; d.WT = wl; d.gain = Fnorm1_g + l * 1024; map = 1; }
            else if ((r -= I_IN) < I_OUT) { d.W = Fw_out + (size_t)l * 1024 * 1024; d.K = 1024; d.N = 1024; d.WT = (bf16*)((unsigned char*)wl + SZ_WIN); d.gain = nullptr; map = 0; }
            else if ((r -= I_OUT) < I_GU) { d.W = Fw_gate_up + (size_t)l * 1024 * NGU; d.K = 1024; d.N = NGU; d.WT = (bf16*)((unsigned char*)wl + SZ_WIN + SZ_WOUT); d.gain = Fnorm2_g + l * 1024; map = 2; }
            else { r -= I_GU; d.W = Fw_down + (size_t)l * DFF * 1024; d.K = DFF; d.N = 1024; d.WT = (bf16*)((unsigned char*)wl + SZ_WIN + SZ_WOUT + SZ_WGU); d.gain = nullptr; map = 0; }
            const int nblk = d.N / 32; d.k0 = 64 * (r / nblk); d.n0 = 32 * (r % nblk); d.f0 = featmap(map, d.n0); return d; };
        f32x4 v[8], vn[8]; float gk[8], gkn[8]; int it = gw; TrItem d, dn;
        if (it < DEPTH * I_L) { d = decode(it); tr_load(d, F.lane, v, gk); }
        while (it < DEPTH * I_L) {
            const int itn = it + NGW;
            if (itn < DEPTH * I_L) { dn = decode(itn); tr_load(dn, F.lane, vn, gkn); }
            tr_store(d, F.lane, v, gk, scr);
#pragma unroll
            for (int i = 0; i < 8; ++i) { v[i] = vn[i]; gk[i] = gkn[i]; }
            d = dn; it = itn;
        }
    }
    bf16* HB = (bf16*)(F.ws + OFF_HB); float* SS = (float*)(F.ws + OFF_SS);
    {
        f32x4 v[4], vn[4]; int m = gw;
#define P0_LOADROW(dst, mm) do { const float* src_ = (mm) < MX ? Fx + (size_t)(mm) * 1024 : Fmeta + (size_t)((mm) - MX) * 1024; \
            _Pragma("unroll") for (int j = 0; j < 4; ++j) dst[j] = ((const f32x4*)src_)[F.lane + 64 * j]; } while (0)
        if (m < MX + NMETA) P0_LOADROW(v, m);
        while (m < MX + NMETA) {
            const int mn = m + NGW;
            if (mn < MX + NMETA) P0_LOADROW(vn, mn);
            float s = 0.f;
#pragma unroll
            for (int j = 0; j < 4; ++j) s += (v[j].x * v[j].x + v[j].y * v[j].y) + (v[j].z * v[j].z + v[j].w * v[j].w);
            s = wave_sum(s);
#pragma unroll
            for (int j = 0; j < 4; ++j) { v2u o; o.x = pk2(v[j].x, v[j].y); o.y = pk2(v[j].z, v[j].w); ((v2u*)(HB + (size_t)m * 1024))[F.lane + 64 * j] = o; }
            if (F.lane < 16) SS[(size_t)m * 16 + F.lane] = F.lane == 0 ? s : 0.f;
#pragma unroll
            for (int j = 0; j < 4; ++j) v[j] = vn[j];
            m = mn;
        }
#undef P0_LOADROW
    }
    float* RC = (float*)(F.ws + OFF_ROPEC); float* RS = (float*)(F.ws + OFF_ROPES);
    for (int idx = (F.vcu * NWAVES + F.wave) * 64 + F.lane; idx < (SEQ + NMETA) * 32; idx += F.G * NWAVES * 64) {
        const int p = idx >> 5, i = idx & 31; const float ang = (float)p * ROPE_INV[i];
        const double a = (double)ang; const double kq = __builtin_rint(a * 0.15915494309189535); const float r = (float)(a - kq * 6.283185307179586);
        RC[idx] = cosf(r); RS[idx] = sinf(r);
    }
    if (blockIdx.x == 0 && F.tid < DEPTH) { const int l = F.tid; float s1 = 0.f, s2 = 0.f;
        for (int i = 0; i < 64; ++i) { s1 += ka->in[I_LQ1][l * 64 + i] * ka->in[I_LK1][l * 64 + i]; s2 += ka->in[I_LQ2][l * 64 + i] * ka->in[I_LK2][l * 64 + i]; }
        const float lam_init = 0.8f - 0.6f * expf(-0.3f * (float)l);
        float* ctl = (float*)(F.ws + OFF_CTL); ctl[CW_LAM + 2 * l] = expf(s1) - expf(s2) + lam_init; ctl[CW_LAM + 2 * l + 1] = 1.0f - lam_init; }
}

__device__ __forceinline__ void meta_attn(const bf16* Q, const bf16* K, const bf16* V, bf16* O, int vh, float* sm, int tid) {
    float* sq = sm; float* sk = sm + 1024; float* sv = sk + 16 * 65; float* sc = sv + 1024;
    const int qcol = (vh >> 1) * 64, vcol = (vh >> 2) * 128 + (vh & 1) * 64;
    for (int idx = tid; idx < 1024; idx += 512) { const int i = idx >> 6, d = idx & 63;
        sq[idx] = bf1(Q[(size_t)(MX + i) * 512 + qcol + d]); sk[i * 65 + d] = bf1(K[(size_t)(MX + i) * 512 + qcol + d]); sv[idx] = bf1(V[(size_t)(MX + i) * 512 + vcol + d]); }
    LDS_BARRIER();
    if (tid < 256) { const int i = tid >> 4, j = tid & 15; float s = 0.f;
        for (int d = 0; d < 64; ++d) s += sq[i * 64 + d] * sk[j * 65 + d];
        sc[tid] = s; }
    LDS_BARRIER();
    { const int i = tid >> 5, d = (tid & 31) * 2; float m = -INFINITY;
      for (int j = 0; j <= i; ++j) m = fmaxf(m, sc[i * 16 + j]);
      float l = 0.f, o0 = 0.f, o1 = 0.f;
      for (int j = 0; j <= i; ++j) { const float p = exp2f(sc[i * 16 + j] - m); l += p; o0 += p * sv[j * 64 + d]; o1 += p * sv[j * 64 + d + 1]; }
      const float rl = 1.0f / l;
      *(unsigned*)(O + (size_t)(MX + i) * 1024 + vh * 64 + d) = pk2(o0 * rl, o1 * rl); }
    LDS_BARRIER();
}

__device__ __forceinline__ void mix_phase(Frame& F, int l) {
    const bf16* O = (const bf16*)(F.ws + OFF_O); const bf16* Z = (const bf16*)(F.ws + OFF_Z); bf16* MIX = (bf16*)(F.ws + OFF_MIX);
    const float* ctl = (const float*)(F.ws + OFF_CTL); const float lam = ctl[CW_LAM + 2 * l], osc = ctl[CW_LAM + 2 * l + 1];
    KArgs ka = kargs();
    const float* subg = ka->in[I_SUBG] + l * 128; const float* cw = ka->in[I_CONVW] + (size_t)l * CONVW * CCH; const float* cb = ka->in[I_CONVB] + l * CCH;
    const float* lg = ka->in[I_CLNG] + l * CCH; const float* lb = ka->in[I_CLNB] + l * CCH;
    f32x2* red = (f32x2*)F.lds;
    const int lane = F.lane, w = F.wave;
    const int tg = w >> 2, cbk = w & 3, c0 = cbk * 128 + 2 * lane;
    f32x2 wk[CONVW];
#pragma unroll
    for (int k = 0; k < CONVW; ++k) wk[k] = *(const f32x2*)(cw + k * CCH + c0);
    const f32x2 bb = *(const f32x2*)(cb + c0), gg = *(const f32x2*)(lg + c0), gb = *(const f32x2*)(lb + c0);
    const int h = lane >> 4, e0 = (lane & 15) * 8, half = e0 >> 6, ec = e0 & 63;
    const f32x4 g0 = *(const f32x4*)(subg + e0), g1 = *(const f32x4*)(subg + e0 + 4);
#define MIX_LOAD(IT, ZW, OA, OB) do { const bool meta_ = (IT) == 2048; const int r0_ = meta_ ? MX : (IT) * 16, rg_ = r0_ + 8 * tg, pg_ = meta_ ? 8 * tg : 16 + (rg_ & 8191), rb_ = rg_ & ~8191; \
        _Pragma("unroll") for (int j = 0; j < 38; ++j) { const int pp = pg_ - 30 + j; ZW[j] = 0u; \
            if (pp >= 0) { const int zr = (meta_ || pp < 16) ? MX + pp : rb_ + pp - 16; ZW[j] = *(const unsigned*)(Z + (size_t)zr * 512 + c0); } } \
        _Pragma("unroll") for (int rr = 0; rr < 2; ++rr) { const int row = r0_ + 2 * w + rr; \
            OA[rr] = *(const v4u*)(O + (size_t)row * 1024 + (h * 4 + half) * 64 + ec); OB[rr] = *(const v4u*)(O + (size_t)row * 1024 + (h * 4 + 2 + half) * 64 + ec); } } while (0)
    unsigned zwv[38], zwn[38]; v4u oa[2], ob[2], oan[2], obn[2];
    if (F.vcu < 2049) MIX_LOAD(F.vcu, zwv, oa, ob);
    for (int it = F.vcu; it < 2049; it += F.G) {
        const bool meta = it == 2048; const int r0 = meta ? MX : it * 16;
        const int rg = r0 + 8 * tg;
        if (it + F.G < 2049) MIX_LOAD(it + F.G, zwn, oan, obn);
        {
#pragma unroll
            for (int rr = 0; rr < 2; ++rr) { const int row = r0 + 2 * w + rr;
                const v4u a = oa[rr], b = ob[rr];
                f32x4 d0, d1;
                d0[0] = bflo(a.x) - lam * bflo(b.x); d0[1] = bfhi(a.x) - lam * bfhi(b.x); d0[2] = bflo(a.y) - lam * bflo(b.y); d0[3] = bfhi(a.y) - lam * bfhi(b.y);
                d1[0] = bflo(a.z) - lam * bflo(b.z); d1[1] = bfhi(a.z) - lam * bfhi(b.z); d1[2] = bflo(a.w) - lam * bflo(b.w); d1[3] = bfhi(a.w) - lam * bfhi(b.w);
                float ss = ((d0[0] * d0[0] + d0[1] * d0[1]) + (d0[2] * d0[2] + d0[3] * d0[3])) + ((d1[0] * d1[0] + d1[1] * d1[1]) + (d1[2] * d1[2] + d1[3] * d1[3]));
                ss = row16_sum(ss);
                const float r = __builtin_amdgcn_rsqf(ss * (1.0f / 128.0f) + 1e-5f) * osc;
                d0 = d0 * r * g0; d1 = d1 * r * g1;
                v4u o; o.x = pk2(d0[0], d0[1]); o.y = pk2(d0[2], d0[3]); o.z = pk2(d1[0], d1[1]); o.w = pk2(d1[2], d1[3]);
                *(v4u*)(MIX + (size_t)row * 1024 + h * 128 + e0) = o; }
        }
        {
            f32x2 accv[8];
            for (int rep_ = 0; rep_ < (PROBE_DUP == 12 ? 3 : 1); ++rep_) {
            if (PROBE_DUP == 12) asm volatile("" : "+v"(zwv[0]), "+v"(zwv[37]));
#pragma unroll
            for (int t = 0; t < 8; ++t) accv[t] = (f32x2){0.f, 0.f};
#pragma unroll
            for (int j = 0; j < 38; ++j) { const unsigned zw = zwv[j];
                const f32x2 zz = {bflo(zw), bfhi(zw)};
#pragma unroll
                for (int t = 0; t < 8; ++t) { const int k = j - t; if (k >= 0 && k < CONVW) accv[t] = __builtin_elementwise_fma(zz, wk[k], accv[t]); }
            }
            }
            float acc0[8], acc1[8], s1[8], s2[8];
#pragma unroll
            for (int t = 0; t < 8; ++t) { acc0[t] = accv[t].x + bb.x; acc1[t] = accv[t].y + bb.y; s1[t] = acc0[t] + acc1[t]; s2[t] = acc0[t] * acc0[t] + acc1[t] * acc1[t]; }
#pragma unroll
            for (int t = 0; t < 8; ++t) { s1[t] = wave_sum(s1[t]); s2[t] = wave_sum(s2[t]); }
            if (lane == 0) {
#pragma unroll
                for (int t = 0; t < 8; ++t) red[(tg * 8 + t) * 4 + cbk] = (f32x2){s1[t], s2[t]};
            }
            LDS_BARRIER();
#pragma unroll
            for (int t = 0; t < 8; ++t) { const f32x2 p0 = red[(tg * 8 + t) * 4 + 0], p1 = red[(tg * 8 + t) * 4 + 1], p2 = red[(tg * 8 + t) * 4 + 2], p3 = red[(tg * 8 + t) * 4 + 3];
                const float mu = ((p0.x + p1.x) + (p2.x + p3.x)) * (1.0f / 512.0f); const float var = ((p0.y + p1.y) + (p2.y + p3.y)) * (1.0f / 512.0f) - mu * mu;
                const float rstd = __builtin_amdgcn_rsqf(fmaxf(var, 0.f) + 1e-5f);
                const float y0 = (acc0[t] - mu) * rstd * gg.x + gb.x, y1 = (acc1[t] - mu) * rstd * gg.y + gb.y;
                const float o0 = y0 * __builtin_amdgcn_rcpf(1.f + __expf(-y0)), o1 = y1 * __builtin_amdgcn_rcpf(1.f + __expf(-y1));
                *(unsigned*)(MIX + (size_t)(rg + t) * 1024 + 512 + c0) = pk2(o0, o1); }
            LDS_BARRIER();
        }
#pragma unroll
        for (int j = 0; j < 38; ++j) zwv[j] = zwn[j];
#pragma unroll
        for (int rr = 0; rr < 2; ++rr) { oa[rr] = oan[rr]; ob[rr] = obn[rr]; }
    }
#undef MIX_LOAD
}

__device__ __forceinline__ void final_phase(Frame& F) {
    const bf16* HB = (const bf16*)(F.ws + OFF_HB); const float* SS = (const float*)(F.ws + OFF_SS);
    const int gw = F.vcu * NWAVES + F.wave, NGW = F.G * NWAVES;
    KArgs ka = kargs(); const float* fg = ka->in[I_FINALG]; float* out = ka->out;
    f32x4 g[4];
#pragma unroll
    for (int j = 0; j < 4; ++j) g[j] = ((const f32x4*)fg)[F.lane + 64 * j];
    {
        v2u w[4], wn[4]; f32x4 sq[4], sqn[4]; int m = gw;
#define FIN_LOAD(W, Q, mm) do { _Pragma("unroll") for (int j = 0; j < 4; ++j) { Q[j] = ((const f32x4*)(SS + (size_t)(mm) * 16))[j]; W[j] = ((const v2u*)(HB + (size_t)(mm) * 1024))[F.lane + 64 * j]; } } while (0)
        if (m < MX) FIN_LOAD(w, sq, m);
        while (m < MX) {
            const int mn = m + NGW;
            if (mn < MX) FIN_LOAD(wn, sqn, mn);
            const f32x4 t = (sq[0] + sq[1]) + (sq[2] + sq[3]);
            const float rs = __builtin_amdgcn_rsqf(((t[0] + t[1]) + (t[2] + t[3])) * (1.0f / 1024.0f) + 1e-5f);
#pragma unroll
            for (int j = 0; j < 4; ++j) { const f32x4 v = {bflo(w[j].x), bfhi(w[j].x), bflo(w[j].y), bfhi(w[j].y)}; ((f32x4*)(out + (size_t)m * 1024))[F.lane + 64 * j] = v * rs * g[j]; }
#pragma unroll
            for (int j = 0; j < 4; ++j) { w[j] = wn[j]; sq[j] = sqn[j]; }
            m = mn;
        }
#undef FIN_LOAD
    }
}

#define RLX_AGENT __ATOMIC_RELAXED, __HIP_MEMORY_SCOPE_AGENT
#define XB_TMO      128
#define XB_XCNT(j)  (256  + 64 * (j))
#define XB_XSUB(j)  (1280 + 64 * (j))
#define XB_XGEN(j)  (2304 + 64 * (j))
#define XB_TOP      3328
#define XB_TOPGEN   3392
#define XCD_BAR_WORDS 3456
#define XB_SPIN_CAP (1u << 18)

__device__ __forceinline__ unsigned xb_ld(unsigned* p)              { return __hip_atomic_load(p, __ATOMIC_RELAXED, __HIP_MEMORY_SCOPE_AGENT); }
__device__ __forceinline__ unsigned xb_add(unsigned* p, unsigned v) { return __hip_atomic_fetch_add(p, v, __ATOMIC_RELAXED, __HIP_MEMORY_SCOPE_AGENT); }
__device__ __forceinline__ unsigned xb_xcc_id() { return (unsigned)__builtin_amdgcn_s_getreg((3 << 11) | 20) & 0xFu; }
#define XB_SPIN(cond, bar) do { unsigned _sp = 0; while (cond) { __builtin_amdgcn_s_sleep(1); \
    if ((++_sp & 255u) == 0u) { if (xb_ld(&(bar)[XB_TMO])) break; if (_sp > XB_SPIN_CAP) { atomicAdd(&(bar)[XB_TMO], 1u); break; } } } } while (0)

struct XcdBarrier {
    unsigned* bar; unsigned x;
    volatile LAS unsigned* st;
};

__device__ __forceinline__ XcdBarrier xcd_barrier_post(unsigned* bar, volatile LAS unsigned* st) {
    XcdBarrier b; b.bar = bar; b.x = xb_xcc_id(); b.st = st;
    if (threadIdx.x == 0) (void)xb_add(&bar[XB_XCNT(b.x)], 1u);
    return b;
}
__device__ __forceinline__ void xcd_barrier_complete(unsigned* bar, unsigned x, unsigned& nloc, unsigned& nx) {
    const unsigned G = gridDim.x * gridDim.y * gridDim.z;
    unsigned sum, cnt, mine, sp = 0u;
    for (;;) {
        sum = 0u; cnt = 0u; mine = 0u;
#pragma unroll
        for (unsigned j = 0; j < 16; ++j) { const unsigned c = xb_ld(&bar[XB_XCNT(j)]); sum += c; cnt += (c > 0u) ? 1u : 0u; mine = (j == x) ? c : mine; }
        if (sum == G) break;
        __builtin_amdgcn_s_sleep(1);
        if ((++sp & 255u) == 0u) { if (xb_ld(&bar[XB_TMO])) break; if (sp > XB_SPIN_CAP) { atomicAdd(&bar[XB_TMO], 1u); break; } }
    }
    nloc = mine > 0u ? mine : 1u; nx = cnt > 0u ? cnt : 1u;
}

__device__ __forceinline__ void xcd_barrier(const XcdBarrier& b) {
    asm volatile("s_waitcnt vmcnt(0)" ::: "memory");
    __syncthreads();
    if (threadIdx.x == 0) {
        unsigned* bar = b.bar;
        __builtin_amdgcn_s_waitcnt(0);
        unsigned nloc = b.st[0], nx = b.st[1];
        if (nloc == 0u) { xcd_barrier_complete(bar, b.x, nloc, nx); b.st[0] = nloc; b.st[1] = nx; }
        const unsigned old = xb_add(&bar[XB_XSUB(b.x)], 1u);
        const unsigned gen = old / nloc;
        if (old + 1u == (gen + 1u) * nloc) {
            __builtin_amdgcn_fence(__ATOMIC_RELEASE, "agent");
            asm volatile("s_waitcnt vmcnt(0)" ::: "memory");
            const unsigned og = xb_add(&bar[XB_TOP], 1u);
            const unsigned tg = og / nx;
            if (og + 1u == (tg + 1u) * nx) xb_add(&bar[XB_TOPGEN], 1u);
            else XB_SPIN(xb_ld(&bar[XB_TOPGEN]) == tg, bar);
            __builtin_amdgcn_fence(__ATOMIC_ACQUIRE, "agent");
            xb_add(&bar[XB_XGEN(b.x)], 1u);
            asm volatile("s_waitcnt vmcnt(0)" ::: "memory");
        } else {
            XB_SPIN(xb_ld(&bar[XB_XGEN(b.x)]) == gen, bar);
            __builtin_amdgcn_fence(__ATOMIC_ACQUIRE, "agent");
            asm volatile("s_waitcnt vmcnt(0)" ::: "memory");
        }
    }
    __syncthreads();
}

constexpr int CW_BAR = 4096;
constexpr int LDS_XB = 147440;

constexpr int LDS_RL = 131072;
template <class Sched> __device__ __forceinline__ void rstd_table(unsigned char* lds, const Sched& S, const float* SS, int tid) {
    LAS float* rl = (LAS float*)((LAS unsigned char*)lds + LDS_RL);
    int pmv[7]; bool ok[7];
#pragma unroll
    for (int j = 0; j < 7; ++j) { pg8::Unit u; u.pm = 0; u.pn = 0; ok[j] = S.next((tid + 512 * j) >> 8, u); pmv[j] = u.pm; }
    float rv[7];
#pragma unroll
    for (int j = 0; j < 7; ++j) rv[j] = ok[j] ? pg8::row_rstd(SS, pmv[j] * 256 + (tid & 255)) : 0.f;
#pragma unroll
    for (int j = 0; j < 7; ++j) if (ok[j]) rl[tid + 512 * j] = rv[j];
    LDS_BARRIER();
}

template <class Epi> __device__ __forceinline__ void mini_gemm(unsigned char* lds, const pg8::bf16_t* A, const pg8::bf16_t* Bt, int K, const Epi& E, int task, int tid) {
    typedef short bf16x8_t __attribute__((ext_vector_type(8)));
    const int lane = tid & 63, wid = __builtin_amdgcn_readfirstlane(tid >> 6), fr = lane & 15, fq = lane >> 4;
    const int pn = task >> 2, wc = task & 3;
    const int kw = K >> 3, kbeg = wid * kw;
    const pg8::bf16_t* ap = A + (size_t)(MX + fr) * K + kbeg + 8 * fq;
    const pg8::bf16_t* bp = Bt + (size_t)(pn * 256 + wc * 32 + 8 * (fr >> 2) + (fr & 3)) * K + kbeg + 8 * fq;
    f32x4 acc[2][2];
#pragma unroll
    for (int bj = 0; bj < 2; ++bj)
#pragma unroll
        for (int n = 0; n < 2; ++n) acc[bj][n] = (f32x4){0.f, 0.f, 0.f, 0.f};
    for (int k0 = 0; k0 < kw; k0 += 128) {
        bf16x8_t a[4], b[4][2][2];
#pragma unroll
        for (int s = 0; s < 4; ++s) { const bool ok = k0 + 32 * s < kw; const int kk = ok ? k0 + 32 * s : 0;
            a[s] = *(const bf16x8_t*)(ap + kk);
#pragma unroll
            for (int bj = 0; bj < 2; ++bj)
#pragma unroll
                for (int n = 0; n < 2; ++n) b[s][bj][n] = *(const bf16x8_t*)(bp + (size_t)(128 * bj + 4 * n) * K + kk); }
        asm volatile("" : "+v"(a[0]), "+v"(a[1]), "+v"(a[2]), "+v"(a[3]), "+v"(b[0][0][0]), "+v"(b[0][0][1]), "+v"(b[0][1][0]), "+v"(b[0][1][1]), "+v"(b[1][0][0]), "+v"(b[1][0][1]), "+v"(b[1][1][0]), "+v"(b[1][1][1]),
                     "+v"(b[2][0][0]), "+v"(b[2][0][1]), "+v"(b[2][1][0]), "+v"(b[2][1][1]), "+v"(b[3][0][0]), "+v"(b[3][0][1]), "+v"(b[3][1][0]), "+v"(b[3][1][1]));
#pragma unroll
        for (int s = 0; s < 4; ++s) { const bool ok = k0 + 32 * s < kw; const bf16x8_t as = ok ? a[s] : (bf16x8_t){0, 0, 0, 0, 0, 0, 0, 0};
#pragma unroll
            for (int bj = 0; bj < 2; ++bj)
#pragma unroll
                for (int n = 0; n < 2; ++n) acc[bj][n] = __builtin_amdgcn_mfma_f32_16x16x32_bf16(b[s][bj][n], as, acc[bj][n], 0, 0, 0); }
    }
    f32x4* red = (f32x4*)lds;
#pragma unroll
    for (int bj = 0; bj < 2; ++bj)
#pragma unroll
        for (int n = 0; n < 2; ++n) red[(wid * 4 + bj * 2 + n) * 64 + lane] = acc[bj][n];
    LDS_BARRIER();
    if (wid == 0) {
        f32x4 sm[4];
#pragma unroll
        for (int q = 0; q < 4; ++q) { sm[q] = red[q * 64 + lane];
#pragma unroll
            for (int w = 1; w < 8; ++w) sm[q] = sm[q] + red[(w * 4 + q) * 64 + lane]; }
        E.rg(sm[0], sm[1], sm[2], sm[3], MX + fr, pn, wc, fq);
    }
    LDS_BARRIER();
}

__global__ void __launch_bounds__(NWAVES * 64, 2) mk_fwd(Args args) {
    extern __shared__ __attribute__((aligned(16))) unsigned char lds[];
    cg::grid_group grid = cg::this_grid();
    if (threadIdx.x < 2) ((volatile LAS unsigned*)((LAS unsigned char*)lds + LDS_XB))[threadIdx.x] = 0u;
    __syncthreads();
    if (!MK_PER_PHASE) (void)xcd_barrier_post((unsigned*)(args.ws + OFF_CTL) + CW_BAR, (volatile LAS unsigned*)((LAS unsigned char*)lds + LDS_XB));
    for (int vp = args.ph_lo; vp < args.ph_hi; ++vp) {
        Frame F;
        { int tid_ = threadIdx.x; asm volatile("" : "+v"(tid_)); F.tid = tid_; }
        unsigned char* ws = kargs()->ws;
        pg8::bf16_t* HB = (pg8::bf16_t*)(ws + OFF_HB); float* SS = (float*)(ws + OFF_SS);
        pg8::bf16_t* Qb = (pg8::bf16_t*)(ws + OFF_Q); pg8::bf16_t* Kb = (pg8::bf16_t*)(ws + OFF_K); pg8::bf16_t* Vb = (pg8::bf16_t*)(ws + OFF_V); pg8::bf16_t* Zb = (pg8::bf16_t*)(ws + OFF_Z);
        pg8::bf16_t* Ob = (pg8::bf16_t*)(ws + OFF_O); pg8::bf16_t* MIX = (pg8::bf16_t*)(ws + OFF_MIX); pg8::bf16_t* ACT = (pg8::bf16_t*)(ws + OFF_ACT);
        LAS unsigned char* lds3 = (LAS unsigned char*)lds;
        F.lds = lds; F.lane = F.tid & 63; F.wave = __builtin_amdgcn_readfirstlane(F.tid >> 6); F.ws = ws;
        F.G = gridDim.x; { const int bx = blockIdx.x; F.vcu = (F.G % 8 == 0) ? (bx % 8) * (F.G / 8) + bx / 8 : bx; }
        if (vp == 0) { p0_prologue(F); if (PROBE_DUP == 6) p0_prologue(F); }
        else if (vp == NVPH - 1) { final_phase(F); if (PROBE_DUP == 8) final_phase(F); }
        else {
            const int l = (vp - 1) / NSLOT, slot = (vp - 1) % NSLOT, sub = (PROBE_DUP >= 0 && PROBE_DUP < 6 && slot > PROBE_DUP) ? slot - 1 : slot;
            const unsigned char* wl = ws + OFF_W + (size_t)l * SZ_WL;
            if (sub == 0) {
                pg8::Gemm g{HB, (const pg8::bf16_t*)wl, MX, NIN, 1024}; pg8::StaticOrder S; S.init(MX, NIN, F.G, (int)blockIdx.x); if (PROBE_DUP == 10) S.rep = 2;
                pg8::EpiQKVZ E{Qb, Kb, Vb, Zb, SS, (const float*)(ws + OFF_ROPEC), (const float*)(ws + OFF_ROPES), kargs()->in[I_BGLU] + l * 1024, (const LAS float*)(lds3 + LDS_RL)};
                rstd_table(lds, S, SS, F.tid);
                pg8::gemm_phase<pg8::EpiQKVZ, pg8::StaticOrder, true, true>(lds3, g, S, E);
                if (F.vcu < NIN / 64) { for (int rep_ = 0; rep_ < (PROBE_DUP == 9 ? 5 : 1); ++rep_) mini_gemm(lds, g.A, g.Bt, 1024, E, F.vcu, F.tid); }
                if (F.vcu == 255) { for (int i = F.tid; i < 48 * 64; i += NWAVES * 64) ((v4u*)(Vb + (size_t)(MX + 16) * 512))[i] = (v4u){0u, 0u, 0u, 0u}; }
            } else if (sub == 1) {
                if (F.vcu < 16) meta_attn((const bf16*)Qb, (const bf16*)Kb, (const bf16*)Vb, (bf16*)Ob, F.vcu, (float*)lds, F.tid);
                const attn_body::AttnTensors AT{(const attn_body::bf16*)Qb, (const attn_body::bf16*)Kb, (const attn_body::bf16*)Vb, (attn_body::bf16*)Ob};
                const attn_body::StaticOrder S(F.vcu);
                attn_body::attn_phase<attn_body::StaticOrder>((char*)lds, AT, S);
            } else if (sub == 2) {
                mix_phase(F, l);
            } else if (sub == 3) {
                pg8::Gemm g{MIX, (const pg8::bf16_t*)(wl + SZ_WIN), MX, 1024, 1024}; pg8::StaticOrder S; S.init(MX, 1024, F.G, (int)blockIdx.x);
                pg8::EpiResid E{HB, SS};
                pg8::gemm_phase<pg8::EpiResid, pg8::StaticOrder, true, true>(lds3, g, S, E);
                if (F.vcu < 1024 / 64) mini_gemm(lds, g.A, g.Bt, 1024, E, F.vcu, F.tid);
            } else if (sub == 4) {
                pg8::Gemm g{HB, (const pg8::bf16_t*)(wl + SZ_WIN + SZ_WOUT), MX, NGU, 1024}; pg8::StaticOrder S; S.init(MX, NGU, F.G, (int)blockIdx.x); if (PROBE_DUP == 11) S.rep = 2;
                pg8::EpiSwiGLU E{ACT, SS, (const LAS float*)(lds3 + LDS_RL)};
                rstd_table(lds, S, SS, F.tid);
                pg8::gemm_phase<pg8::EpiSwiGLU, pg8::StaticOrder, true, true>(lds3, g, S, E);
                if (F.vcu < NGU / 64) mini_gemm(lds, g.A, g.Bt, 1024, E, F.vcu, F.tid);
            } else {
                pg8::Gemm g{ACT, (const pg8::bf16_t*)(wl + SZ_WIN + SZ_WOUT + SZ_WGU), MX, 1024, DFF}; pg8::StaticOrder S; S.init(MX, 1024, F.G, (int)blockIdx.x);
                pg8::EpiResid E{HB, SS};
                pg8::gemm_phase<pg8::EpiResid, pg8::StaticOrder, true, true>(lds3, g, S, E);
                if (F.vcu < 1024 / 64) mini_gemm(lds, g.A, g.Bt, DFF, E, F.vcu, F.tid);
            }
        }
        if (vp + 1 < args.ph_hi) {
            if (args.ph_lo < 0) grid.sync();
            { XcdBarrier xb; xb.bar = (unsigned*)(kargs()->ws + OFF_CTL) + CW_BAR; xb.x = xb_xcc_id(); xb.st = (volatile LAS unsigned*)((LAS unsigned char*)lds + LDS_XB); xcd_barrier(xb); if (PROBE_DUP == 7) xcd_barrier(xb); }
        }
    }
}

extern "C" void kernel_launch(void* const* d_in, const int* in_sizes, int n_in, void* d_out, int out_size, void* d_ws, size_t ws_size, hipStream_t stream) {
    static int grid = 0;
    if (grid == 0) {
        if (n_in != 19 || in_sizes[0] != MX * 1024 || out_size != MX * 1024 || ws_size < WS_END) { fprintf(stderr, "kernel_launch: unexpected shapes (n_in %d, in0 %d, out %d, ws %zu < %zu)\n", n_in, n_in > 0 ? in_sizes[0] : -1, out_size, ws_size, (size_t)WS_END); grid = -1; return; }
        int dev = 0, cus = 0, per_cu = 0;
        if (hipGetDevice(&dev) != hipSuccess || hipDeviceGetAttribute(&cus, hipDeviceAttributeMultiprocessorCount, dev) != hipSuccess) { grid = -1; return; }
        if (hipFuncSetAttribute((const void*)mk_fwd, hipFuncAttributeMaxDynamicSharedMemorySize, LDS_BYTES) != hipSuccess) { fprintf(stderr, "kernel_launch: hipFuncSetAttribute failed\n"); grid = -1; return; }
        if (hipOccupancyMaxActiveBlocksPerMultiprocessor(&per_cu, (const void*)mk_fwd, NWAVES * 64, LDS_BYTES) != hipSuccess || per_cu < 1) { fprintf(stderr, "kernel_launch: occupancy query says %d\n", per_cu); per_cu = 1; }
        (void)hipGetLastError();
        grid = cus;
        if (grid != 256) fprintf(stderr, "kernel_launch: %d CUs; the attention schedule assumes 256\n", grid);
    }
    if (grid < 0) return;
    Args a{};
    for (int i = 0; i < 19; ++i) a.in[i] = (const float*)d_in[i];
    a.out = (float*)d_out; a.ws = (unsigned char*)d_ws;
#if MK_PER_PHASE
    for (int ph = 0; ph < NVPH; ++ph) { a.ph_lo = ph; a.ph_hi = ph + 1; hipLaunchKernelGGL(mk_fwd, dim3(grid), dim3(NWAVES * 64), LDS_BYTES, stream, a); }
#else
    a.ph_lo = 0; a.ph_hi = NVPH;
    if (hipMemsetAsync((char*)d_ws + OFF_CTL + (size_t)CW_BAR * 4, 0, (size_t)XCD_BAR_WORDS * 4, stream) != hipSuccess) { fprintf(stderr, "kernel_launch: memset of the barrier words failed\n"); return; }
    void* kargs[] = {&a};
    hipError_t e = hipLaunchCooperativeKernel((const void*)mk_fwd, dim3(grid), dim3(NWAVES * 64), kargs, LDS_BYTES, stream);
    if (e != hipSuccess) fprintf(stderr, "kernel_launch: cooperative launch failed: %s (grid %d)\n", hipGetErrorString(e), grid);
#endif
}
```

```cpp
#include <hip/hip_runtime.h>
#include <hip/hip_cooperative_groups.h>
#include <cstdio>
#include <cstdint>
constexpr int NB = 4, SEQ = 8192, DMODEL = 1024, NMETA = 16, DEPTH = 4;
constexpr int MX = NB * SEQ;
constexpr int MROWS = MX + 256;
constexpr int NIN = 2560, DFF = 2816, NGU = 2 * DFF, CONVW = 31, CCH = 512;
constexpr int NPHASE = 2 + 6 * DEPTH;
constexpr size_t al4k(size_t x) { return (x + 4095) & ~(size_t)4095; }
constexpr size_t OFF_CTL = 0, SZ_CTL = 1u << 20;
constexpr size_t SZ_ROPE = al4k((size_t)(SEQ + NMETA) * 32 * 4);
constexpr size_t OFF_ROPEC = OFF_CTL + SZ_CTL, OFF_ROPES = OFF_ROPEC + SZ_ROPE;
constexpr size_t OFF_SS = OFF_ROPES + SZ_ROPE, SZ_SS = al4k((size_t)MROWS * 16 * 4);
constexpr size_t SZ_WIN = (size_t)NIN * 1024 * 2, SZ_WOUT = (size_t)1024 * 1024 * 2, SZ_WGU = (size_t)NGU * 1024 * 2, SZ_WDN = (size_t)1024 * DFF * 2;
constexpr size_t SZ_WL = SZ_WIN + SZ_WOUT + SZ_WGU + SZ_WDN;
constexpr size_t OFF_W = OFF_SS + SZ_SS;
constexpr size_t OFF_H = OFF_W + DEPTH * SZ_WL, SZ_H = (size_t)MROWS * 1024 * 4;
constexpr size_t OFF_HB = OFF_H + SZ_H, SZ_HB = (size_t)MROWS * 1024 * 2;
constexpr size_t SZ_QK = (size_t)MROWS * 512 * 2;
constexpr size_t OFF_Q = OFF_HB + SZ_HB, OFF_K = OFF_Q + SZ_QK, OFF_V = OFF_K + SZ_QK, OFF_Z = OFF_V + SZ_QK, OFF_O = OFF_Z + SZ_QK;
constexpr size_t WS_END = OFF_O + (size_t)MROWS * 1024 * 2;
constexpr size_t OFF_MIX = OFF_Q;
constexpr size_t OFF_ACT = OFF_Q;
static_assert(OFF_ACT + (size_t)MROWS * DFF * 2 <= WS_END && WS_END <= ((size_t)512 << 20), "d_ws map");
constexpr int CW_LAM = 64;
namespace pg8 { constexpr size_t EO_Q = OFF_Q, EO_K = OFF_K, EO_V = OFF_V, EO_Z = OFF_Z, EO_SS = OFF_SS, EO_RC = OFF_ROPEC, EO_RS = OFF_ROPES, EO_H = OFF_H, EO_HB = OFF_HB, EO_ACT = OFF_ACT; }
namespace pg8 {
#define PG8_LAS __attribute__((address_space(3)))
typedef unsigned short bf16_t;
typedef short bf16x8 __attribute__((ext_vector_type(8)));
typedef float f32x4 __attribute__((ext_vector_type(4)));
typedef unsigned u32x4 __attribute__((ext_vector_type(4)));
constexpr int BM = 256, BK = 64, HALF = 128, HTB = HALF * BK * 2  , STAGE_BYTES = 8 * HTB, NXCD = 8, WGM = 8;

__host__ __device__ __forceinline__ int lds_byte(int r, int c) { const int st = (r >> 4) * 2 + (c >> 5), rr = r & 15, cc = c & 31, ob = rr * 64 + cc * 2; return st * 1024 + (ob ^ (((ob >> 9) & 1) << 5)); }
__host__ __device__ __forceinline__ void stage_rc(int b, int& R, int& C) { const int st = b / 1024, sb = b % 1024, swz = sb ^ (((sb >> 9) & 1) << 5); R = (st >> 1) * 16 + swz / 64; C = (st & 1) * 32 + (swz % 64) / 2; }
__host__ __device__ __forceinline__ int perm32(int rho) { const int n = rho >> 4, i = rho & 15; return 8 * (i >> 2) + 4 * n + (i & 3); }

struct Unit { int pm, pn; };
struct Gemm { const bf16_t* A; const bf16_t* Bt; int M, N, K; };

struct StaticOrder {
    int nM, nN, nwg, G, c;
    __host__ __device__ void init(int M, int N, int G_, int c_) { nM = M / BM; nN = N / BM; nwg = nM * nN; G = G_; c = c_; }
    int rep = 1;
    __host__ __device__ bool next(int i, Unit& u) const {
        i = i / rep; const long L = (long)i * G + c; if (L >= nwg) return false;
        int wgid = (int)L; { const int q = nwg / NXCD, r = nwg % NXCD, xcd = wgid % NXCD, off = wgid / NXCD; wgid = (xcd < r ? xcd * (q + 1) : r * (q + 1) + (xcd - r) * q) + off; }
        const int nig = WGM * nN, gid = wgid / nig, fm = gid * WGM, gsz = (nM - fm) < WGM ? (nM - fm) : WGM;
        u.pm = fm + ((wgid % nig) % gsz); u.pn = (wgid % nig) / gsz; return true;
    }
    __device__ __forceinline__ void a_ready(const Unit&) const {}
    __device__ __forceinline__ void done(const Unit&) const {}
};


__device__ __forceinline__ unsigned cvt_pk_bf16(float lo, float hi) { unsigned r; asm volatile("v_cvt_pk_bf16_f32 %0, %1, %2" : "=v"(r) : "v"(lo), "v"(hi)); return r; }
#ifndef PG8_NT_STORE
#define PG8_NT_STORE 0
#endif
__device__ __forceinline__ void store8(bf16_t* p, const f32x4 a, const f32x4 b) {
    u32x4 w; w.x = cvt_pk_bf16(a[0], a[1]); w.y = cvt_pk_bf16(a[2], a[3]); w.z = cvt_pk_bf16(b[0], b[1]); w.w = cvt_pk_bf16(b[2], b[3]);
#if PG8_NT_STORE
    __builtin_nontemporal_store(w, (u32x4*)p);
#else
    *(u32x4*)p = w;
#endif
}
constexpr int MXROWS = 32768;
constexpr float RMS_EPS = 1e-5f;
constexpr float QC2 = 0.125f * 1.4426950408889634f;
__device__ __forceinline__ float row_rstd(const float* SS, int row) {
    const f32x4* p = (const f32x4*)(SS + (size_t)row * 16);
    const f32x4 a = p[0], b = p[1], c = p[2], d = p[3];
    const float s = (((a[0] + a[1]) + (a[2] + a[3])) + ((b[0] + b[1]) + (b[2] + b[3]))) + (((c[0] + c[1]) + (c[2] + c[3])) + ((d[0] + d[1]) + (d[2] + d[3])));
    return __builtin_amdgcn_rsqf(s * (1.0f / 1024.0f) + RMS_EPS);
}
__device__ __forceinline__ f32x4 sigmoid4(const f32x4 g) {
    f32x4 r; r[0] = __builtin_amdgcn_rcpf(1.f + __expf(-g[0])); r[1] = __builtin_amdgcn_rcpf(1.f + __expf(-g[1])); r[2] = __builtin_amdgcn_rcpf(1.f + __expf(-g[2])); r[3] = __builtin_amdgcn_rcpf(1.f + __expf(-g[3])); return r; }

#define PG8_EPI_LOOP_RS() \
    __device__ __forceinline__ void operator()(const f32x4 (&acc)[2][2][4][2], const Unit& u, int wr, int wc, int fr, int fq, int ui) const { \
        const int row0 = u.pm * BM + wr * 64 + fr; const PG8_LAS float* rl = RL + ui * BM + wr * 64 + fr; \
        _Pragma("unroll") for (int ai = 0; ai < 2; ++ai) _Pragma("unroll") for (int m = 0; m < 4; ++m) \
            rgs(acc[ai][0][m][0], acc[ai][0][m][1], acc[ai][1][m][0], acc[ai][1][m][1], row0 + ai * HALF + m * 16, u.pn, wc, fq, rl[ai * HALF + m * 16]); }

struct EpiQKVZ {
    static constexpr bool PERM = true, AFTER_DRAIN = false;
    bf16_t *Q, *K, *V, *Z; const float* SS; const float* RC; const float* RS; const float* bglu; const PG8_LAS float* RL;
    __device__ __forceinline__ void rg(const f32x4 a00, const f32x4 a01, const f32x4 a10, const f32x4 a11, int row, int pn, int wc, int fq) const { rgs(a00, a01, a10, a11, row, pn, wc, fq, row_rstd(SS, row)); }
    __device__ __forceinline__ void rgs(const f32x4 a00, const f32x4 a01, const f32x4 a10, const f32x4 a11, int row, int pn, int wc, int fq, const float rs0) const {
        if (pn < 4) {
            bf16_t* dst = (pn < 2) ? Q : K; const float sc = (pn < 2) ? QC2 : 1.f; const int colb = ((pn & 1) * 4 + wc) * 64 + 8 * fq;
            const float rs = rs0 * sc;
            const int pos = row < MXROWS ? 16 + (row & 8191) : row - MXROWS;
            const f32x4 c0 = *(const f32x4*)(RC + pos * 32 + 8 * fq), c1 = *(const f32x4*)(RC + pos * 32 + 8 * fq + 4);
            const f32x4 s0 = *(const f32x4*)(RS + pos * 32 + 8 * fq), s1 = *(const f32x4*)(RS + pos * 32 + 8 * fq + 4);
            const f32x4 x1a = a00 * rs, x1b = a01 * rs, x2a = a10 * rs, x2b = a11 * rs;
            store8(dst + (size_t)row * 512 + colb, x1a * c0 - x2a * s0, x1b * c1 - x2b * s1);
            store8(dst + (size_t)row * 512 + colb + 32, x2a * c0 + x1a * s0, x2b * c1 + x1b * s1);
        } else if (pn < 6) {
            const int col0 = (pn - 4) * BM + wc * 32 + 8 * fq; const float rs = rs0;
            store8(V + (size_t)row * 512 + col0, a00 * rs, a01 * rs); store8(V + (size_t)row * 512 + col0 + HALF, a10 * rs, a11 * rs);
        } else {
            const int cc = (pn - 6) * HALF + wc * 32 + 8 * fq; const float rs = rs0;
            const f32x4 ba0 = *(const f32x4*)(bglu + cc), ba1 = *(const f32x4*)(bglu + cc + 4), bg0 = *(const f32x4*)(bglu + 512 + cc), bg1 = *(const f32x4*)(bglu + 512 + cc + 4);
            const f32x4 x0 = a00 * rs + ba0, x1 = a01 * rs + ba1, g0 = a10 * rs + bg0, g1 = a11 * rs + bg1;
            store8(Z + (size_t)row * 512 + cc, x0 * sigmoid4(g0), x1 * sigmoid4(g1));
        }
    }
    __device__ __forceinline__ void operator()(const f32x4 (&acc)[2][2][4][2], const Unit& u, int wr, int wc, int fr, int fq, int ui) const {
        const int row0 = u.pm * BM + wr * 64 + fr, pn = u.pn; const PG8_LAS float* rl = RL + ui * BM + wr * 64 + fr;
        if (pn < 4) {
            bf16_t* dst = (pn < 2) ? Q : K; const float sc = (pn < 2) ? QC2 : 1.f; const int colb = ((pn & 1) * 4 + wc) * 64 + 8 * fq;
#pragma unroll
            for (int ai = 0; ai < 2; ++ai) { f32x4 c0[4], c1[4], s0[4], s1[4];
#pragma unroll
                for (int m = 0; m < 4; ++m) { const int pos = 16 + ((row0 + ai * HALF + m * 16) & 8191);
                    c0[m] = *(const f32x4*)(RC + pos * 32 + 8 * fq); c1[m] = *(const f32x4*)(RC + pos * 32 + 8 * fq + 4); s0[m] = *(const f32x4*)(RS + pos * 32 + 8 * fq); s1[m] = *(const f32x4*)(RS + pos * 32 + 8 * fq + 4); }
#pragma unroll
                for (int m = 0; m < 4; ++m) { const int row = row0 + ai * HALF + m * 16; const float rs = rl[ai * HALF + m * 16] * sc;
                    const f32x4 x1a = acc[ai][0][m][0] * rs, x1b = acc[ai][0][m][1] * rs, x2a = acc[ai][1][m][0] * rs, x2b = acc[ai][1][m][1] * rs;
                    store8(dst + (size_t)row * 512 + colb, x1a * c0[m] - x2a * s0[m], x1b * c1[m] - x2b * s1[m]);
                    store8(dst + (size_t)row * 512 + colb + 32, x2a * c0[m] + x1a * s0[m], x2b * c1[m] + x1b * s1[m]); }
                asm volatile("" ::: "memory"); }
        } else if (pn < 6) {
            const int col0 = (pn - 4) * BM + wc * 32 + 8 * fq;
#pragma unroll
            for (int ai = 0; ai < 2; ++ai)
#pragma unroll
                for (int m = 0; m < 4; ++m) { const int row = row0 + ai * HALF + m * 16; const float rs = rl[ai * HALF + m * 16];
                    store8(V + (size_t)row * 512 + col0, acc[ai][0][m][0] * rs, acc[ai][0][m][1] * rs); store8(V + (size_t)row * 512 + col0 + HALF, acc[ai][1][m][0] * rs, acc[ai][1][m][1] * rs); }
        } else {
            const int cc = (pn - 6) * HALF + wc * 32 + 8 * fq;
            const f32x4 ba0 = *(const f32x4*)(bglu + cc), ba1 = *(const f32x4*)(bglu + cc + 4), bg0 = *(const f32x4*)(bglu + 512 + cc), bg1 = *(const f32x4*)(bglu + 512 + cc + 4);
#pragma unroll
            for (int ai = 0; ai < 2; ++ai)
#pragma unroll
                for (int m = 0; m < 4; ++m) { const int row = row0 + ai * HALF + m * 16; const float rs = rl[ai * HALF + m * 16];
                    const f32x4 x0 = acc[ai][0][m][0] * rs + ba0, x1 = acc[ai][0][m][1] * rs + ba1, g0 = acc[ai][1][m][0] * rs + bg0, g1 = acc[ai][1][m][1] * rs + bg1;
                    store8(Z + (size_t)row * 512 + cc, x0 * sigmoid4(g0), x1 * sigmoid4(g1)); }
        }
    }
};
__device__ __forceinline__ f32x4 bf_lo4(const u32x4 w) { f32x4 r; r[0] = __builtin_bit_cast(float, w.x << 16); r[1] = __builtin_bit_cast(float, w.x & 0xffff0000u); r[2] = __builtin_bit_cast(float, w.y << 16); r[3] = __builtin_bit_cast(float, w.y & 0xffff0000u); return r; }
__device__ __forceinline__ f32x4 bf_hi4(const u32x4 w) { f32x4 r; r[0] = __builtin_bit_cast(float, w.z << 16); r[1] = __builtin_bit_cast(float, w.z & 0xffff0000u); r[2] = __builtin_bit_cast(float, w.w << 16); r[3] = __builtin_bit_cast(float, w.w & 0xffff0000u); return r; }
struct EpiResid {
    static constexpr bool PERM = true, AFTER_DRAIN = false;
    bf16_t* HB; float* SS;
    __device__ __forceinline__ void rg(const f32x4 a00, const f32x4 a01, const f32x4 a10, const f32x4 a11, int row, int pn, int wc, int fq) const {
        const int col0 = pn * BM + wc * 32 + 8 * fq; const bf16_t* hp = HB + (size_t)row * 1024 + col0;
        rgw(a00, a01, a10, a11, row, pn, wc, fq, *(const u32x4*)(hp), *(const u32x4*)(hp + HALF));
    }
    __device__ __forceinline__ void rgw(const f32x4 a00, const f32x4 a01, const f32x4 a10, const f32x4 a11, int row, int pn, int wc, int fq, const u32x4 w0, const u32x4 w1) const {
        const int col0 = pn * BM + wc * 32 + 8 * fq; bf16_t* hp = HB + (size_t)row * 1024 + col0;
        const f32x4 h0 = bf_lo4(w0) + a00, h1 = bf_hi4(w0) + a01, h2 = bf_lo4(w1) + a10, h3 = bf_hi4(w1) + a11;
        float ssq = (((h0[0] * h0[0] + h0[1] * h0[1]) + (h0[2] * h0[2] + h0[3] * h0[3])) + ((h1[0] * h1[0] + h1[1] * h1[1]) + (h1[2] * h1[2] + h1[3] * h1[3])))
                  + (((h2[0] * h2[0] + h2[1] * h2[1]) + (h2[2] * h2[2] + h2[3] * h2[3])) + ((h3[0] * h3[0] + h3[1] * h3[1]) + (h3[2] * h3[2] + h3[3] * h3[3])));
        store8(hp, h0, h1); store8(hp + HALF, h2, h3);
        ssq += __shfl_xor(ssq, 16); ssq += __shfl_xor(ssq, 32);
        if (fq == 0) SS[(size_t)row * 16 + pn * 4 + wc] = ssq;
    }
    __device__ __forceinline__ void operator()(const f32x4 (&acc)[2][2][4][2], const Unit& u, int wr, int wc, int fr, int fq, int) const {
        const int row0 = u.pm * BM + wr * 64 + fr; const int col0 = u.pn * BM + wc * 32 + 8 * fq;
        u32x4 w[2][2][2];
#define PG8_RES_LOAD(slot, b) do { _Pragma("unroll") for (int m2 = 0; m2 < 2; ++m2) { const int g_ = 2 * (b) + m2; \
            const bf16_t* hp = HB + (size_t)(row0 + (g_ >> 2) * HALF + (g_ & 3) * 16) * 1024 + col0; w[slot][m2][0] = *(const u32x4*)(hp); w[slot][m2][1] = *(const u32x4*)(hp + HALF); } } while (0)
        PG8_RES_LOAD(0, 0);
#pragma unroll
        for (int b = 0; b < 4; ++b) {
            if (b + 1 < 4) { if (((b + 1) & 1) == 0) PG8_RES_LOAD(0, b + 1); else PG8_RES_LOAD(1, b + 1); }
#pragma unroll
            for (int m2 = 0; m2 < 2; ++m2) { const int g_ = 2 * b + m2, ai = g_ >> 2, m = g_ & 3;
                rgw(acc[ai][0][m][0], acc[ai][0][m][1], acc[ai][1][m][0], acc[ai][1][m][1], row0 + ai * HALF + m * 16, u.pn, wc, fq, w[b & 1][m2][0], w[b & 1][m2][1]); }
            asm volatile("" ::: "memory");
        }
#undef PG8_RES_LOAD
    }
};
struct EpiSwiGLU {
    static constexpr bool PERM = true, AFTER_DRAIN = false;
    bf16_t* ACT; const float* SS; const PG8_LAS float* RL;
    __device__ __forceinline__ void rg(const f32x4 a00, const f32x4 a01, const f32x4 a10, const f32x4 a11, int row, int pn, int wc, int fq) const { rgs(a00, a01, a10, a11, row, pn, wc, fq, row_rstd(SS, row)); }
    __device__ __forceinline__ void rgs(const f32x4 a00, const f32x4 a01, const f32x4 a10, const f32x4 a11, int row, int pn, int wc, int fq, const float rs) const {
        const int col0 = pn * HALF + wc * 32 + 8 * fq;
        const f32x4 g0 = a00 * rs, g1 = a01 * rs, u0 = a10 * rs, u1 = a11 * rs;
        store8(ACT + (size_t)row * 2816 + col0, g0 * sigmoid4(g0) * u0, g1 * sigmoid4(g1) * u1);
    }
    PG8_EPI_LOOP_RS()
};
template <class Epi, class Sched, bool ALIGN_EPI = false, bool SP2 = false>
__device__ __forceinline__ void gemm_phase(PG8_LAS unsigned char* lds, const Gemm g, const Sched& S, const Epi& E) {
    int tid_ = threadIdx.x; asm volatile("" : "+v"(tid_));
    const int tid = tid_, wid = __builtin_amdgcn_readfirstlane(tid >> 6), lane = tid & 63, wr = wid >> 2, wc = wid & 3, fr = lane & 15, fq = lane >> 4;
    const int K = g.K, nt = K / BK;
    unsigned voffA[2], voffB[2];
#pragma unroll
    for (int i = 0; i < 2; ++i) { int R, C; stage_rc(tid * 16 + i * 8192, R, C); const int Rb = Epi::PERM ? ((R & ~31) + perm32(R & 31)) : R;
        voffA[i] = (unsigned)(R * K + C) * 2u; voffB[i] = (unsigned)(Rb * K + C) * 2u; }
    const size_t kstep = (size_t)(BK * 2);
    const size_t hstep = (size_t)HALF * K * 2;
    const size_t tstep = 2 * hstep;
    const unsigned ldsw = (unsigned)wid * 1024u;
    const int aoff = lds_byte(wr * 64 + fr, fq * 8), boff = lds_byte(wc * 32 + fr, fq * 8);
#define PG8_SA(b, h) (((b) * 2 + (h)) * HTB)
#define PG8_SB(b, h) ((4 + (b) * 2 + (h)) * HTB)
#define PG8_STAGE(bufoff, gbase, voff) do { _Pragma("unroll") for (int _i = 0; _i < 2; ++_i) \
        __builtin_amdgcn_global_load_lds((const unsigned*)((const char*)(gbase) + (voff)[_i]), (PG8_LAS unsigned*)(lds + (bufoff) + ldsw + _i * 8192), 16, 0, 0); } while (0)
#define PG8_LDA(dst, b, h) do { _Pragma("unroll") for (int m = 0; m < 4; ++m) _Pragma("unroll") for (int k = 0; k < 2; ++k) dst[m][k] = *(const PG8_LAS bf16x8*)(lds + PG8_SA(b, h) + aoff + m * 2048 + k * 1024); } while (0)
#define PG8_LDB(dst, b, h) do { _Pragma("unroll") for (int n = 0; n < 2; ++n) _Pragma("unroll") for (int k = 0; k < 2; ++k) dst[n][k] = *(const PG8_LAS bf16x8*)(lds + PG8_SB(b, h) + boff + n * 2048 + k * 1024); } while (0)
#define PG8_MMA(ai, bj, At, Bt) do { __builtin_amdgcn_s_setprio(1); _Pragma("unroll") for (int m = 0; m < 4; ++m) _Pragma("unroll") for (int n = 0; n < 2; ++n) _Pragma("unroll") for (int k = 0; k < 2; ++k) \
        acc[ai][bj][m][n] = __builtin_amdgcn_mfma_f32_16x16x32_bf16(Bt[n][k], At[m][k], acc[ai][bj][m][n], 0, 0, 0); __builtin_amdgcn_s_setprio(0); } while (0)
#define PG8_WAIT_V(n) asm volatile("s_waitcnt vmcnt(" #n ")" ::: "memory")
#define PG8_WAIT_L(n) asm volatile("s_waitcnt lgkmcnt(" #n ")" ::: "memory")
#define PG8_BAR __builtin_amdgcn_s_barrier()
#define PG8_SCHED __builtin_amdgcn_sched_barrier(0)
    Unit cur, nxt; int ui = 0;
    if (!S.next(0, cur)) return;
    f32x4 acc[2][2][4][2];
#pragma unroll
    for (int a = 0; a < 2; ++a)
#pragma unroll
        for (int b = 0; b < 2; ++b)
#pragma unroll
            for (int m = 0; m < 4; ++m)
#pragma unroll
                for (int n = 0; n < 2; ++n) acc[a][b][m][n] = (f32x4){0.f, 0.f, 0.f, 0.f};
    bf16x8 At[4][2], B0[2][2], B1[2][2];
    const char* cA = (const char*)g.A + (size_t)cur.pm * tstep; const char* cB = (const char*)g.Bt + (size_t)cur.pn * tstep;
    S.a_ready(cur);
    if constexpr (SP2) {
        PG8_STAGE(PG8_SB(0, 0), cB, voffB); PG8_STAGE(PG8_SB(0, 1), cB + hstep, voffB); PG8_STAGE(PG8_SA(0, 0), cA, voffA); PG8_STAGE(PG8_SA(0, 1), cA + hstep, voffA);
        if (wr == 1) PG8_BAR;
        PG8_WAIT_V(2); PG8_BAR;
        PG8_STAGE(PG8_SB(1, 0), cB + kstep, voffB); PG8_STAGE(PG8_SA(1, 0), cA + kstep, voffA); PG8_STAGE(PG8_SB(1, 1), cB + hstep + kstep, voffB);
        PG8_WAIT_V(6); PG8_BAR;
    } else {
        PG8_STAGE(PG8_SB(0, 0), cB, voffB); PG8_STAGE(PG8_SA(0, 0), cA, voffA); PG8_STAGE(PG8_SB(0, 1), cB + hstep, voffB); PG8_STAGE(PG8_SA(0, 1), cA + hstep, voffA);
        if (wr == 1) PG8_BAR;
        PG8_WAIT_V(4); PG8_BAR;
        PG8_STAGE(PG8_SB(1, 0), cB + kstep, voffB); PG8_STAGE(PG8_SA(1, 0), cA + kstep, voffA); PG8_STAGE(PG8_SB(1, 1), cB + hstep + kstep, voffB);
        PG8_WAIT_V(6); PG8_BAR;
    }
    for (;;) {
        const bool has_next = S.next(ui + 1, nxt);
        const char* nA = has_next ? (const char*)g.A + (size_t)nxt.pm * tstep : cA; const char* nB = has_next ? (const char*)g.Bt + (size_t)nxt.pn * tstep : cB;
        for (int t = 0; t < nt; t += 2) {
            const bool last = (t == nt - 2);
            const char* a1 = cA + (size_t)(t + 1) * kstep;
            const char* a2 = last ? nA : cA + (size_t)(t + 2) * kstep; const char* b2 = last ? nB : cB + (size_t)(t + 2) * kstep;
            const char* a3 = a2 + kstep; const char* b3 = b2 + kstep;
            if (last && has_next) S.a_ready(nxt);
            if constexpr (SP2) {
            PG8_LDB(B0, 0, 0); PG8_LDB(B1, 0, 1); PG8_SCHED; PG8_LDA(At, 0, 0); PG8_STAGE(PG8_SA(1, 1), a1 + hstep, voffA);
            PG8_WAIT_V(8); PG8_WAIT_L(0); PG8_BAR; PG8_MMA(0, 0, At, B0); PG8_MMA(0, 1, At, B1); PG8_BAR; PG8_SCHED;
            PG8_LDA(At, 0, 1); PG8_STAGE(PG8_SB(0, 0), b2, voffB); PG8_STAGE(PG8_SB(0, 1), b2 + hstep, voffB); PG8_STAGE(PG8_SA(0, 0), a2, voffA);
            PG8_WAIT_V(8); PG8_WAIT_L(0); PG8_BAR; PG8_MMA(1, 0, At, B0); PG8_MMA(1, 1, At, B1); PG8_BAR; PG8_SCHED;
            PG8_LDB(B0, 1, 0); PG8_LDB(B1, 1, 1); PG8_SCHED; PG8_LDA(At, 1, 0); PG8_STAGE(PG8_SA(0, 1), a2 + hstep, voffA);
            PG8_WAIT_V(8); PG8_WAIT_L(0); PG8_BAR; PG8_MMA(0, 0, At, B0); PG8_MMA(0, 1, At, B1); PG8_BAR; PG8_SCHED;
            PG8_LDA(At, 1, 1); PG8_STAGE(PG8_SB(1, 0), b3, voffB); PG8_STAGE(PG8_SB(1, 1), b3 + hstep, voffB); PG8_STAGE(PG8_SA(1, 0), a3, voffA);
            PG8_WAIT_V(8); PG8_WAIT_L(0); PG8_BAR; PG8_MMA(1, 0, At, B0); PG8_MMA(1, 1, At, B1); PG8_BAR; PG8_SCHED;
            } else {
            PG8_LDB(B0, 0, 0); PG8_SCHED; PG8_LDA(At, 0, 0); PG8_STAGE(PG8_SA(1, 1), a1 + hstep, voffA);
            PG8_WAIT_L(8); PG8_BAR; PG8_WAIT_L(0); PG8_MMA(0, 0, At, B0); PG8_BAR; PG8_SCHED;
            PG8_LDB(B1, 0, 1); PG8_STAGE(PG8_SB(0, 0), b2, voffB);
            PG8_BAR; PG8_WAIT_L(0); PG8_MMA(0, 1, At, B1); PG8_BAR;
            PG8_LDA(At, 0, 1); PG8_STAGE(PG8_SA(0, 0), a2, voffA);
            PG8_BAR; PG8_WAIT_L(0); PG8_MMA(1, 0, At, B0); PG8_BAR; PG8_SCHED;
            PG8_STAGE(PG8_SB(0, 1), b2 + hstep, voffB);
            PG8_WAIT_V(6); PG8_BAR; PG8_MMA(1, 1, At, B1); PG8_BAR;
            PG8_LDB(B0, 1, 0); PG8_SCHED; PG8_LDA(At, 1, 0); PG8_STAGE(PG8_SA(0, 1), a2 + hstep, voffA);
            PG8_WAIT_L(8); PG8_BAR; PG8_WAIT_L(0); PG8_MMA(0, 0, At, B0); PG8_BAR; PG8_SCHED;
            PG8_LDB(B1, 1, 1); PG8_STAGE(PG8_SB(1, 0), b3, voffB);
            PG8_BAR; PG8_WAIT_L(0); PG8_MMA(0, 1, At, B1); PG8_BAR;
            PG8_LDA(At, 1, 1); PG8_STAGE(PG8_SA(1, 0), a3, voffA);
            PG8_BAR; PG8_WAIT_L(0); PG8_MMA(1, 0, At, B0); PG8_BAR; PG8_SCHED;
            PG8_STAGE(PG8_SB(1, 1), b3 + hstep, voffB);
            PG8_WAIT_V(6); PG8_BAR; PG8_MMA(1, 1, At, B1); PG8_BAR;
            }
        }
        if constexpr (ALIGN_EPI) { if (wr == 0) PG8_BAR; }
        if constexpr (!Epi::AFTER_DRAIN) { E(acc, cur, wr, wc, fr, fq, ui); S.done(cur); }
        if (!has_next) break;
#pragma unroll
        for (int a = 0; a < 2; ++a)
#pragma unroll
            for (int b = 0; b < 2; ++b)
#pragma unroll
                for (int m = 0; m < 4; ++m)
#pragma unroll
                    for (int n = 0; n < 2; ++n) acc[a][b][m][n] = (f32x4){0.f, 0.f, 0.f, 0.f};
        cur = nxt; cA = nA; cB = nB; ++ui;
        if constexpr (ALIGN_EPI) { if (wr == 1) PG8_BAR; }
    }
    PG8_WAIT_V(0);
    if constexpr (!ALIGN_EPI) { if (wr == 0) PG8_BAR; }
    PG8_BAR;
    if constexpr (Epi::AFTER_DRAIN) { E.fused(acc, cur, wr, wc, fr, fq, lds, wid, lane); S.done(cur); }
#undef PG8_SA
#undef PG8_SB
#undef PG8_STAGE
#undef PG8_LDA
#undef PG8_LDB
#undef PG8_MMA
#undef PG8_WAIT_V
#undef PG8_WAIT_L
#undef PG8_BAR
#undef PG8_SCHED
}
}
#include <hip/hip_bf16.h>
#include <cmath>
namespace attn_body {
using bf16=__hip_bfloat16;
using bf16x8=__attribute__((ext_vector_type(8)))short;
using s16x4=__attribute__((ext_vector_type(4)))short;
using f32x16=__attribute__((ext_vector_type(16)))float;
using u32x4=__attribute__((ext_vector_type(4)))unsigned;
constexpr int SEQ=8192,D=64,PQ=512,PK=512,PV=512,PO=1024,METAROW=32768;
constexpr int NW=8,QBLK=32,QB=QBLK*NW,KVBLK=64,NQB=SEQ/QB;
constexpr int ATTN_UNIT_ROWS=QB;
__device__ __forceinline__ int crow(int r,int hi){return (r&3)+8*(r>>2)+4*hi;}
#define SBAR() __builtin_amdgcn_sched_barrier(0)
__device__ __forceinline__ void cmask(f32x16&p0,f32x16&p1,int jb,int qrel,int hi){
  const float NEG=-INFINITY; int kb=64*jb+4*hi;
  #pragma unroll
  for(int r=0;r<16;++r){int kv=kb+(r&3)+8*(r>>2); if(kv>qrel)p0[r]=NEG; if(kv+32>qrel)p1[r]=NEG;}
}

constexpr int NSLOT=3, SLOTB=8192, VSLOTB=2*SLOTB;
constexpr int LDS_K=0, LDS_V=NSLOT*SLOTB, LDS_WS=LDS_V+NSLOT*VSLOTB, LDS_OST=LDS_WS+NW*64*4, LDS_QS=LDS_OST+NW*4096, LDS_BYTES=LDS_QS+NW*4096;
constexpr float C2=0.125f*1.4426950408889634f;
__device__ __forceinline__ void glds16(const void*sbase,unsigned voff,unsigned lds_dst){unsigned keep;
  asm volatile("s_mov_b32 %0, m0\n\ts_mov_b32 m0, %3\n\ts_nop 0\n\tglobal_load_lds_dwordx4 %1, %2\n\ts_mov_b32 m0, %0":"=&s"(keep):"v"(voff),"s"(sbase),"s"(lds_dst):"memory");}
template<int IMM> __device__ __forceinline__ void glds16o(const void*sbase,unsigned voff,unsigned lds_dst){unsigned keep;
  asm volatile("s_mov_b32 %0, m0\n\ts_mov_b32 m0, %3\n\ts_nop 0\n\tglobal_load_lds_dwordx4 %1, %2 offset:%c4\n\ts_mov_b32 m0, %0":"=&s"(keep):"v"(voff),"s"(sbase),"s"(lds_dst),"i"(IMM):"memory");}
__device__ __forceinline__ float max3f(float a,float b,float c){float r;asm("v_max3_f32 %0, %1, %2, %3":"=v"(r):"v"(a),"v"(b),"v"(c));return r;}
__device__ __forceinline__ float max2f(float a,float b){float r;asm("v_max_f32_e32 %0, %1, %2":"=v"(r):"v"(a),"v"(b));return r;}
__device__ __forceinline__ float fadd_s(float a,float b){float r;asm("v_add_f32_e32 %0, %1, %2":"=v"(r):"v"(a),"v"(b));return r;}
__device__ __forceinline__ float fsub_s(float a,float b){float r;asm("v_sub_f32_e32 %0, %1, %2":"=v"(r):"v"(a),"v"(b));return r;}
typedef float f32x2_t __attribute__((ext_vector_type(2))); typedef __bf16 bf16x2_t __attribute__((ext_vector_type(2)));
__device__ __forceinline__ unsigned cvtpk_s(float lo,float hi){f32x2_t v={lo,hi};bf16x2_t b=__builtin_convertvector(v,bf16x2_t);return __builtin_bit_cast(unsigned,b);}
#define WAIT_BAR(N) asm volatile("s_waitcnt vmcnt(" #N ") lgkmcnt(0)\n\ts_barrier":::"memory")

typedef __attribute__((address_space(3))) const char* lds_cptr;
__device__ __forceinline__ void qkt(f32x16&p0,f32x16&p1,const char*Kslot,lds_cptr qsp,int r32,int hi){
  const char*kb=Kslot+hi*1024+r32*16; const f32x16 z=f32x16{};
  #pragma unroll
  for(int d0=0;d0<4;++d0){
    const bf16x8 b0=*reinterpret_cast<const bf16x8*>(kb+d0*2048);
    const bf16x8 b1=*reinterpret_cast<const bf16x8*>(kb+d0*2048+512);
    const bf16x8 q=*(const __attribute__((address_space(3))) bf16x8*)(qsp+d0*1024);
    if(d0==0){p0=__builtin_amdgcn_mfma_f32_32x32x16_bf16(b0,q,z,0,0,0);p1=__builtin_amdgcn_mfma_f32_32x32x16_bf16(b1,q,z,0,0,0);}
    else{p0=__builtin_amdgcn_mfma_f32_32x32x16_bf16(b0,q,p0,0,0,0);p1=__builtin_amdgcn_mfma_f32_32x32x16_bf16(b1,q,p1,0,0,0);}}
}
typedef short v4i16_t __attribute__((ext_vector_type(4)));
__device__ __forceinline__ void kload8(bf16x8*kf,lds_cptr kp){
  kf[0]=*(const __attribute__((address_space(3))) bf16x8*)(kp);      kf[1]=*(const __attribute__((address_space(3))) bf16x8*)(kp+512);
  kf[2]=*(const __attribute__((address_space(3))) bf16x8*)(kp+2048); kf[3]=*(const __attribute__((address_space(3))) bf16x8*)(kp+2560);
  kf[4]=*(const __attribute__((address_space(3))) bf16x8*)(kp+4096); kf[5]=*(const __attribute__((address_space(3))) bf16x8*)(kp+4608);
  kf[6]=*(const __attribute__((address_space(3))) bf16x8*)(kp+6144); kf[7]=*(const __attribute__((address_space(3))) bf16x8*)(kp+6656);
}
__device__ __forceinline__ void kload2(bf16x8*kf,lds_cptr kp,int j){ kf[2*j]=*(const __attribute__((address_space(3))) bf16x8*)(kp+j*2048); kf[2*j+1]=*(const __attribute__((address_space(3))) bf16x8*)(kp+j*2048+512); }
__device__ __forceinline__ s16x4 vtr(lds_cptr p){ return __builtin_bit_cast(s16x4,__builtin_amdgcn_ds_read_tr16_b64_v4i16((__attribute__((address_space(3))) v4i16_t*)p)); }
__device__ __forceinline__ float rowmax(const f32x16&p0,const f32x16&p1){
  float a=max3f(p0[0],p0[1],p1[0]),b=max3f(p0[2],p0[3],p1[1]);a=max3f(a,p1[2],p1[3]);
  #pragma unroll
  for(int r=4;r<16;r+=4){a=max3f(a,p0[r],p0[r+1]);b=max3f(b,p0[r+2],p0[r+3]);a=max3f(a,p1[r],p1[r+1]);b=max3f(b,p1[r+2],p1[r+3]);}
  const float m=max2f(a,b);
  auto rr=__builtin_amdgcn_permlane32_swap(__float_as_uint(m),__float_as_uint(m),false,false);
  return max2f(__uint_as_float(rr[0]),__uint_as_float(rr[1]));
}
__device__ __forceinline__ void pv(f32x16*o,int vb,bf16x8 pa0,bf16x8 pa1,bf16x8 pa2,bf16x8 pa3){
  #pragma unroll
  for(int d0=0;d0<4;++d0){s16x4 lo[4],hi[4];
    #pragma unroll
    for(int ks=0;ks<4;++ks){
      asm volatile("ds_read_b64_tr_b16 %0,%1 offset:%c2":"=&v"(lo[ks]):"v"(vb),"i"(d0*4096+ks*1024):"memory");
      asm volatile("ds_read_b64_tr_b16 %0,%1 offset:%c2":"=&v"(hi[ks]):"v"(vb),"i"(d0*4096+ks*1024+512):"memory");}
    asm volatile("s_waitcnt lgkmcnt(0)":::"memory");SBAR();
    #define PK(k) (bf16x8){lo[k][0],lo[k][1],lo[k][2],lo[k][3],hi[k][0],hi[k][1],hi[k][2],hi[k][3]}
    o[d0]=__builtin_amdgcn_mfma_f32_32x32x16_bf16(pa0,PK(0),o[d0],0,0,0);
    o[d0]=__builtin_amdgcn_mfma_f32_32x32x16_bf16(pa1,PK(1),o[d0],0,0,0);
    o[d0]=__builtin_amdgcn_mfma_f32_32x32x16_bf16(pa2,PK(2),o[d0],0,0,0);
    o[d0]=__builtin_amdgcn_mfma_f32_32x32x16_bf16(pa3,PK(3),o[d0],0,0,0);
    #undef PK
  }
}

#ifndef ATTN_STORE16
#define ATTN_STORE16(p,v) (*(u32x4*)(p)=(v))
#endif
template<int THRL> __device__ __forceinline__ void attn_unit(int b,int vh,int qb,int nqb,bool pre,const bf16*Q,const bf16*__restrict__ K,const bf16*__restrict__ V,bf16*O,char*shm){
  int tid_=threadIdx.x; asm volatile("":"+v"(tid_)); const int tid=tid_,lane=tid&63,r32=lane&31,hi=lane>>5; const int wid=__builtin_amdgcn_readfirstlane(tid>>6);
  const int qcol=vh*64, vcol=(vh>>1)*128, ocol=vh*128;
  const long rowbase=(long)b*SEQ; const int q0=qb*QB;
  const bf16*Qw=Q+(rowbase+q0+wid*QBLK)*PQ+qcol;
  const unsigned lds0=(unsigned)(uintptr_t)shm;
  float*wsf=(float*)(shm+LDS_WS)+wid*64;
  const unsigned koff=(unsigned)((lane*PK+wid*8+qcol)*2), voff=(unsigned)(((16*(wid&3)+(lane>>2))*PV+(wid>>2)*32+(lane&3)*8+vcol)*2);
  const bf16*ksrc=K+(rowbase-KVBLK)*PK, *kmeta=K+(long)METAROW*PK;
  const bf16*vsrc=V+(rowbase-KVBLK)*PV, *vmeta=V+(long)METAROW*PV;
  const unsigned kdst=lds0+LDS_K+wid*1024, vdst=lds0+LDS_V+wid*1024;
  #define DMA_K(t,slot) glds16(((t)==0?kmeta:ksrc+(long)(t)*KVBLK*PK),koff,(unsigned)__builtin_amdgcn_readfirstlane(kdst+(slot)))
  #define DMA_V(t,slot) do{ const bf16*vs_=((t)==0?vmeta:vsrc+(long)(t)*KVBLK*PV); const unsigned vd_=(unsigned)__builtin_amdgcn_readfirstlane(vdst+2*(slot)); glds16(vs_,voff,vd_); glds16(vs_,voff+128u,vd_+8192); }while(0)
  const int vb0=(int)(lds0+LDS_V)+((lane>>4)&1)*32+(lane&3)*8+(4*hi+((lane&15)>>2))*64;
  const char*Kbase=shm+LDS_K; bf16x8 kf[8];
  const lds_cptr shm3=(lds_cptr)shm; const lds_cptr kp0=shm3+LDS_K+hi*1024+r32*16; const lds_cptr vp0=shm3+LDS_V+((lane>>4)&1)*32+(lane&3)*8+(4*hi+((lane&15)>>2))*64;
  const int NT=(q0+QB)/KVBLK+1;
  if(!pre){ DMA_K(0,0);DMA_V(0,0);DMA_K(1,SLOTB); }
  const lds_cptr qsp=shm3+LDS_QS+wid*4096+lane*16;
  if(!pre){ bf16x8 qt[4];
    #pragma unroll
    for(int d0=0;d0<4;++d0)qt[d0]=*reinterpret_cast<const bf16x8*>(&Qw[(long)r32*PQ+d0*16+hi*8]);
    #pragma unroll
    for(int d0=0;d0<4;++d0)*(__attribute__((address_space(3))) bf16x8*)(shm3+LDS_QS+wid*4096+lane*16+d0*1024)=qt[d0]; }
  float mhat=0.f,l_reg=0.f;f32x16 o[4];o[0]=f32x16{};o[1]=f32x16{};o[2]=f32x16{};o[3]=f32x16{};f32x16 negm=f32x16{};asm volatile("":"+v"(negm));
  const int qrel=wid*QBLK+r32;
  #define CMASK(P0,P1,t) do{int jb_=(t)-(NT-4); if(jb_>=0)cmask(P0,P1,jb_,qrel,hi);}while(0)
  bool resc=false;
  #define START(P0,P1) do{ const float rm=rowmax(P0,P1); resc=false; \
    { const float dl=rm; mhat=fadd_s(mhat,dl); \
      _Pragma("unroll") for(int r=0;r<16;++r){P0[r]=fsub_s(P0[r],dl);P1[r]=fsub_s(P1[r],dl);} \
      _Pragma("unroll") for(int r=0;r<16;++r)negm[r]=-mhat; asm volatile("":"+v"(negm)); } \
    _Pragma("unroll") for(int r=0;r<16;++r)P0[r]=__builtin_amdgcn_exp2f(P0[r]); }while(0)
  #define RESC() do{ if(resc){ asm volatile("s_waitcnt lgkmcnt(0)":::"memory"); \
      _Pragma("unroll") for(int d_=0;d_<4;++d_) _Pragma("unroll") for(int r=0;r<16;++r)o[d_][r]*=wsf[crow(r,hi)]; } }while(0)
  f32x16 pA0,pA1,pB0,pB1;
  int sl_prev=0,sl_cur=0,sl_next=SLOTB;
  #define ROT() do{sl_prev=sl_cur;sl_cur=sl_next;sl_next=(sl_next==(NSLOT-1)*SLOTB)?0:sl_next+SLOTB;}while(0)
  DMA_K(2,2*SLOTB);
  if(pre){ asm volatile("s_waitcnt lgkmcnt(0)\n\ts_barrier":::"memory"); }
  else { WAIT_BAR(4); }
  qkt(pB0,pB1,Kbase,qsp,r32,hi);asm volatile("s_nop 15\n\ts_nop 7":"+v"(pB0),"+v"(pB1));
  { _Pragma("unroll") for(int r_=0;r_<16;++r_){ if(r_>=8)pB0[r_]=-INFINITY; pB1[r_]=-INFINITY; } }
  START(pB0,pB1);
  _Pragma("unroll") for(int r=0;r<16;++r)pB1[r]=__builtin_amdgcn_exp2f(pB1[r]);
  WAIT_BAR(0);
  DMA_K(3,0);DMA_V(1,SLOTB);
  ROT();
  kload8(kf,kp0+sl_cur);
  WAIT_BAR(3);
  s16x4 vlo[8],vhi[8]; u32x4 pw0,pw1,pw2,pw3;
  #define PKW(P,B) cvtpk_s(P[B],P[B+1])
  #define PAF(k) __builtin_bit_cast(bf16x8,pw##k)
  #define VFR(i) (bf16x8){vlo[i][0],vlo[i][1],vlo[i][2],vlo[i][3],vhi[i][0],vhi[i][1],vhi[i][2],vhi[i][3]}
  #define PIN(x) asm volatile("":"+v"(x))
  #define MX3(a,b,c) __builtin_fmaxf(__builtin_fmaxf((a),(b)),(c))
  #define GAPA(MF,A0,A1,A2,A3,W0,W1,PW) do{ MF; sacc+=A0; sacc+=A1; sacc+=A2; sacc+=A3; PIN(sacc); W0; W1; PIN(PW); SBAR(); }while(0)
  #define EX(v) __builtin_amdgcn_exp2f(v)
  #define GAPB2(MF,X,B) do{ MF; X[B]=EX(X[B]); X[B+1]=EX(X[B+1]); PIN(X); SBAR(); }while(0)
  #define VRD(i) do{ vlo[i]=vtr(vp_+(((i)>>2)*4096+((i)&3)*1024)); vhi[i]=vtr(vp_+(((i)>>2)*4096+((i)&3)*1024+512)); }while(0)
  #define VRD2(i) do{ vlo[i]=vtr(vp_+((((i)>>2)+2)*4096+((i)&3)*1024)); vhi[i]=vtr(vp_+((((i)>>2)+2)*4096+((i)&3)*1024+512)); }while(0)
  #define KRD(G,j) do{ if(G){ kload2(kf,kp0+sl_next,j); SBAR(); } }while(0)
  #define QL(d) (*(const __attribute__((address_space(3))) bf16x8*)(qsp+(d)*1024))
  #define MF32(a,b,c) __builtin_amdgcn_mfma_f32_32x32x16_bf16(a,b,c,0,0,0)
  #define STEP(C0,C1,P0,P1,t,GK,GV,GL) do{ SBAR(); \
    const lds_cptr vp_=vp0+2*sl_prev; \
    const bf16x8 q0_=QL(0), q1_=QL(1); \
    VRD(0); SBAR(); float sacc=(P0[0]+P0[1]); \
    GAPA(C0=MF32(kf[0],q0_,negm), P0[2],P0[3],P0[4],P0[5],     pw0[0]=PKW(P0,0), pw0[1]=PKW(P0,2), pw0); \
    VRD(4); SBAR(); GAPA(C1=MF32(kf[1],q0_,negm), P0[6],P0[7],P0[8],P0[9],     pw0[2]=PKW(P0,4), pw0[3]=PKW(P0,6), pw0); \
    const bf16x8 q2_=QL(2); \
    VRD(1); SBAR(); GAPA(C0=MF32(kf[2],q1_,C0),   P0[10],P0[11],P0[12],P0[13], pw1[0]=PKW(P0,8), pw1[1]=PKW(P0,10), pw1); \
    VRD(5); SBAR(); GAPA(C1=MF32(kf[3],q1_,C1),   P0[14],P0[15],P1[0],P1[1],   pw1[2]=PKW(P0,12),pw1[3]=PKW(P0,14), pw1); \
    const bf16x8 q3_=QL(3); \
    VRD(2); SBAR(); GAPA(C0=MF32(kf[4],q2_,C0),   P1[2],P1[3],P1[4],P1[5],     pw2[0]=PKW(P1,0), pw2[1]=PKW(P1,2), pw2); \
    VRD(6); SBAR(); GAPA(C1=MF32(kf[5],q2_,C1),   P1[6],P1[7],P1[8],P1[9],     pw2[2]=PKW(P1,4), pw2[3]=PKW(P1,6), pw2); \
    VRD(3); SBAR(); GAPA(C0=MF32(kf[6],q3_,C0),   P1[10],P1[11],P1[12],P1[13], pw3[0]=PKW(P1,8), pw3[1]=PKW(P1,10), pw3); \
    VRD(7); SBAR(); GAPA(C1=MF32(kf[7],q3_,C1),   P1[14],P1[15],0.f,0.f,       pw3[2]=PKW(P1,12),pw3[3]=PKW(P1,14), pw3); \
    l_reg+=sacc; \
    if(GK){DMA_K((t)+3,sl_cur);} if(GV){DMA_V((t)+1,sl_next);} \
    CMASK(C0,C1,t); \
    { float a=MX3(C0[0],C0[1],C1[0]),b=MX3(C0[2],C0[3],C1[1]); a=MX3(a,C1[2],C1[3]); \
      _Pragma("unroll") for(int r=4;r<16;r+=4){a=MX3(a,C0[r],C0[r+1]);b=MX3(b,C0[r+2],C0[r+3]);a=MX3(a,C1[r],C1[r+1]);b=MX3(b,C1[r+2],C1[r+3]);} \
      float rm=__builtin_fmaxf(a,b); { auto rr=__builtin_amdgcn_permlane32_swap(__float_as_uint(rm),__float_as_uint(rm),false,false); rm=__builtin_fmaxf(__uint_as_float(rr[0]),__uint_as_float(rr[1])); } \
      resc=false; \
      if(__builtin_expect(__any(rm>(float)THRL),0)){ const float dl=__builtin_fmaxf(rm,0.f); mhat+=dl; \
        _Pragma("unroll") for(int r=0;r<16;++r){C0[r]-=dl;C1[r]-=dl;} \
        _Pragma("unroll") for(int r=0;r<16;++r)negm[r]=-mhat; asm volatile("":"+v"(negm)); \
        const float f=__builtin_amdgcn_exp2f(-dl); l_reg*=f; if(hi==0)wsf[r32]=f; resc=true; } } \
    SBAR(); \
    GAPB2(o[0]=MF32(PAF(0),VFR(0),o[0]), C0,0);  VRD2(0); SBAR(); \
    GAPB2(o[1]=MF32(PAF(0),VFR(4),o[1]), C0,2);  VRD2(4); SBAR(); \
    GAPB2(o[0]=MF32(PAF(1),VFR(1),o[0]), C0,4);  VRD2(1); SBAR(); \
    GAPB2(o[1]=MF32(PAF(1),VFR(5),o[1]), C0,6);  VRD2(5); SBAR(); \
    GAPB2(o[0]=MF32(PAF(2),VFR(2),o[0]), C0,8);  VRD2(2); SBAR(); \
    GAPB2(o[1]=MF32(PAF(2),VFR(6),o[1]), C0,10); VRD2(6); SBAR(); \
    GAPB2(o[0]=MF32(PAF(3),VFR(3),o[0]), C0,12); VRD2(3); SBAR(); \
    GAPB2(o[1]=MF32(PAF(3),VFR(7),o[1]), C0,14); VRD2(7); SBAR(); \
    GAPB2(o[2]=MF32(PAF(0),VFR(0),o[2]), C1,0); \
    GAPB2(o[3]=MF32(PAF(0),VFR(4),o[3]), C1,2); \
    KRD(GL,0); GAPB2(o[2]=MF32(PAF(1),VFR(1),o[2]), C1,4); \
    KRD(GL,1); GAPB2(o[3]=MF32(PAF(1),VFR(5),o[3]), C1,6); \
    KRD(GL,2); GAPB2(o[2]=MF32(PAF(2),VFR(2),o[2]), C1,8); \
    KRD(GL,3); GAPB2(o[3]=MF32(PAF(2),VFR(6),o[3]), C1,10); \
    GAPB2(o[2]=MF32(PAF(3),VFR(3),o[2]), C1,12); \
    GAPB2(o[3]=MF32(PAF(3),VFR(7),o[3]), C1,14); \
    }while(0)
  #define ENDW(tt) do{ if((tt)+3<NT){WAIT_BAR(3);} else if((tt)+2<NT){WAIT_BAR(2);} else {WAIT_BAR(0);} }while(0)
  STEP(pA0,pA1,pB0,pB1,1,(1+3<NT),true,true); ENDW(1); RESC(); ROT();
  int t=2;
  #undef CMASK
  #define CMASK(P0,P1,t) do{}while(0)
  for(;t+6<NT;t+=2){
    STEP(pB0,pB1,pA0,pA1,t,true,true,true);     WAIT_BAR(3); RESC(); ROT();
    STEP(pA0,pA1,pB0,pB1,t+1,true,true,true);   WAIT_BAR(3); RESC(); ROT();
  }
  #undef CMASK
  #define CMASK(P0,P1,t) do{int jb_=(t)-(NT-4); if(jb_>=0)cmask(P0,P1,jb_,qrel,hi);}while(0)
  for(;t+1<NT;t+=2){
    STEP(pB0,pB1,pA0,pA1,t,(t+3<NT),(t+1<NT),(t+1<NT));       ENDW(t);   RESC(); ROT();
    STEP(pA0,pA1,pB0,pB1,t+1,(t+4<NT),(t+2<NT),(t+2<NT));     ENDW(t+1); RESC(); ROT();
  }
  STEP(pB0,pB1,pA0,pA1,NT-1,false,false,false); RESC();
  { float sacc=pB0[0]+pB0[1]; _Pragma("unroll") for(int r=2;r<16;++r)sacc+=pB0[r]; _Pragma("unroll") for(int r=0;r<16;++r)sacc+=pB1[r]; l_reg+=sacc;
    pw0=(u32x4){PKW(pB0,0),PKW(pB0,2),PKW(pB0,4),PKW(pB0,6)};pw1=(u32x4){PKW(pB0,8),PKW(pB0,10),PKW(pB0,12),PKW(pB0,14)};pw2=(u32x4){PKW(pB1,0),PKW(pB1,2),PKW(pB1,4),PKW(pB1,6)};pw3=(u32x4){PKW(pB1,8),PKW(pB1,10),PKW(pB1,12),PKW(pB1,14)};
    SBAR(); pv(o,vb0+2*sl_cur,PAF(0),PAF(1),PAF(2),PAF(3)); }
  #undef PKW
  #undef PAF
  #undef VFR
  #undef PIN
  #undef MX3
  #undef GAPA
  #undef GAPB2
  #undef VRD2
  #undef QL
  #undef MF32
  #undef EX
  #undef VRD
  #undef KRD
  #undef STEP
  #undef ENDW
  bf16x8 qn[4];
  if(nqb>=0){ asm volatile("s_waitcnt lgkmcnt(0)\n\ts_barrier":::"memory");
    DMA_K(0,0);DMA_V(0,0);DMA_K(1,SLOTB);
    const bf16*Qn=Q+(rowbase+(long)nqb*QB+wid*QBLK)*PQ+qcol;
    #pragma unroll
    for(int d0=0;d0<4;++d0)qn[d0]=*reinterpret_cast<const bf16x8*>(&Qn[(long)r32*PQ+d0*16+hi*8]); }
  {auto rr=__builtin_amdgcn_permlane32_swap(__float_as_uint(l_reg),__float_as_uint(l_reg),false,false);l_reg=__uint_as_float(rr[0])+__uint_as_float(rr[1]);}
  if(hi==0)wsf[32+r32]=l_reg;asm volatile("s_waitcnt lgkmcnt(0)":::"memory");
  float rli[16];
  #pragma unroll
  for(int r=0;r<16;++r)rli[r]=__builtin_amdgcn_rcpf(wsf[32+crow(r,hi)]);
  bf16*Ow=O+(rowbase+q0+wid*QBLK)*PO+ocol;
  { bf16*stg=(bf16*)(shm+LDS_OST)+wid*2048;
    #pragma unroll
    for(int ps=0;ps<2;++ps){
    #pragma unroll
    for(int r=0;r<16;++r){const int orow=crow(r,hi);
      #pragma unroll
      for(int d0=0;d0<2;++d0)stg[orow*64+d0*32+r32]=__float2bfloat16(o[2*ps+d0][r]*rli[r]);}
    asm volatile("s_waitcnt lgkmcnt(0)":::"memory");
    #pragma unroll
    for(int i=0;i<4;++i){const int row=i*8+(lane>>3),ch=lane&7; const u32x4 v=*(const u32x4*)(stg+row*64+ch*8); ATTN_STORE16(Ow+(long)row*PO+ps*64+ch*8,v);}
    asm volatile("s_waitcnt lgkmcnt(0)":::"memory"); } }
  if(nqb>=0){
    #pragma unroll
    for(int d0=0;d0<4;++d0)*(__attribute__((address_space(3))) bf16x8*)(shm3+LDS_QS+wid*4096+lane*16+d0*1024)=qn[d0];
  } else { asm volatile("s_waitcnt lgkmcnt(0)\n\ts_barrier":::"memory"); }
  #undef DMA_K
  #undef DMA_V
  #undef CMASK
  #undef START
  #undef RESC
  #undef ROT
}
constexpr int ATTN_LDS_BYTES=LDS_BYTES;
struct AttnTensors { const bf16* Q; const bf16* K; const bf16* V; bf16* O; };
struct AttnUnit { int bvh; int qb; };
struct StaticOrder {
  int vcu;
  __device__ __forceinline__ explicit StaticOrder(int v):vcu(v){}
  __device__ __forceinline__ bool next(int i,AttnUnit&u)const{ if(i>=4)return false; const int s=vcu&7; u.bvh=vcu>>3; const int j=(i>>1)*8+s; u.qb=(i&1)?31-j:j; return true; }
};
template<class Sched,int THRL=8> __device__ __forceinline__ void attn_phase(char*lds,const AttnTensors&T,const Sched&S){
  AttnUnit u,un; bool pre=false; bool has=S.next(0,u);
  for(int i=0;has;++i){ const bool hn=S.next(i+1,un)&&un.bvh==u.bvh; attn_unit<THRL>(u.bvh>>3,u.bvh&7,u.qb,hn?un.qb:-1,pre,T.Q,T.K,T.V,T.O,lds); pre=hn; has=S.next(i+1,un); u=un; }
}
#undef SBAR
#undef WAIT_BAR
}
namespace cg = cooperative_groups;
constexpr int NWAVES = 8;
#ifndef MK_PER_PHASE
#define MK_PER_PHASE 0
#endif
#ifndef PROBE_DUP
#define PROBE_DUP -1
#endif
constexpr int NSLOT = (PROBE_DUP >= 0 && PROBE_DUP < 6) ? 7 : 6;
constexpr int NVPH = 2 + NSLOT * DEPTH;
constexpr int RING_BYTES = 131072, LDS_BYTES = 147456;

#define LAS __attribute__((address_space(3)))
typedef unsigned short bf16;
typedef unsigned v4u __attribute__((ext_vector_type(4)));
typedef unsigned v2u __attribute__((ext_vector_type(2)));
typedef float f32x4 __attribute__((ext_vector_type(4)));
typedef float f32x2 __attribute__((ext_vector_type(2)));
#define LDS_WAIT() asm volatile("s_waitcnt lgkmcnt(0)" ::: "memory")
#define LDS_BARRIER() asm volatile("s_waitcnt lgkmcnt(0)\n\ts_barrier" ::: "memory")
__device__ __forceinline__ unsigned f2bf(float f) { unsigned u = __builtin_bit_cast(unsigned, f); return (u + 0x7fffu + ((u >> 16) & 1u)) >> 16; }
__device__ __forceinline__ unsigned pk2(float lo, float hi) { return f2bf(lo) | (f2bf(hi) << 16); }
__device__ __forceinline__ float bflo(unsigned w) { return __builtin_bit_cast(float, w << 16); }
__device__ __forceinline__ float bfhi(unsigned w) { return __builtin_bit_cast(float, w & 0xffff0000u); }
__device__ __forceinline__ float bf1(bf16 h) { return __builtin_bit_cast(float, (unsigned)h << 16); }
#define DPP_ADD(v, ctrl, rowmask) v += __builtin_bit_cast(float, __builtin_amdgcn_update_dpp(0, __builtin_bit_cast(int, v), ctrl, rowmask, 0xF, false))
__device__ __forceinline__ float row16_sum(float v) {
    DPP_ADD(v, 0xB1, 0xF); DPP_ADD(v, 0x4E, 0xF); DPP_ADD(v, 0x141, 0xF); DPP_ADD(v, 0x140, 0xF); return v; }
__device__ __forceinline__ float wave_sum(float v) {
    v = row16_sum(v); DPP_ADD(v, 0x142, 0xA); DPP_ADD(v, 0x143, 0xC);
    return __builtin_bit_cast(float, __builtin_amdgcn_readlane(__builtin_bit_cast(int, v), 63)); }

struct Args { const float* in[19]; float* out; unsigned char* ws; int ph_lo, ph_hi; };

typedef const __attribute__((address_space(4))) Args* KArgs;
__device__ __forceinline__ KArgs kargs() { KArgs p = (KArgs)__builtin_amdgcn_kernarg_segment_ptr(); asm volatile("" : "+s"(p)); return p; }
enum { I_X = 0, I_META, I_NORM1G, I_WIN, I_BGLU, I_CONVW, I_CONVB, I_CLNG, I_CLNB, I_LQ1, I_LK1, I_LQ2, I_LK2, I_SUBG, I_WOUT, I_NORM2G, I_WGU, I_WDN, I_FINALG };
struct Frame {
    unsigned char* lds; int tid, lane, wave, vcu, G;
    unsigned char* ws;
};

__device__ __forceinline__ int featmap(int map, int n0) {
    const int pn = n0 >> 8, j = n0 & 255, bj = j >> 7, wc = (j & 127) >> 5;
    if (map == 1) { if (pn < 4) return (pn >> 1) * 512 + ((pn & 1) * 4 + wc) * 64 + bj * 32; if (pn < 6) return n0; return 1536 + bj * 512 + (pn - 6) * 128 + (j & 127); }
    if (map == 2) return bj * DFF + pn * 128 + (j & 127);
    return n0;
}
struct TrItem { const float* W; bf16* WT; const float* gain; int K, N, k0, n0, f0; };
__device__ __forceinline__ void tr_load(const TrItem& d, int lane, f32x4 (&v)[8], float (&gk)[8]) {
#pragma unroll
    for (int i = 0; i < 8; ++i) { const int kk = 8 * i + (lane >> 3); v[i] = *(const f32x4*)(d.W + (size_t)(d.k0 + kk) * d.N + d.f0 + 4 * (lane & 7)); gk[i] = d.gain ? d.gain[d.k0 + kk] : 1.0f; }
}
__device__ __forceinline__ void tr_store(const TrItem& d, int lane, const f32x4 (&v)[8], const float (&gk)[8], float* scr) {
#pragma unroll
    for (int i = 0; i < 8; ++i) { const int kk = 8 * i + (lane >> 3); float* p = scr + kk * 33 + 4 * (lane & 7); p[0] = v[i].x * gk[i]; p[1] = v[i].y * gk[i]; p[2] = v[i].z * gk[i]; p[3] = v[i].w * gk[i]; }
    LDS_WAIT(); asm volatile("" ::: "memory");
    const int c = lane & 7;
#pragma unroll
    for (int j = 0; j < 4; ++j) { const int n = (lane >> 3) + 8 * j; const float* s = scr + (8 * c) * 33 + n;
        v4u o; o.x = pk2(s[0 * 33], s[1 * 33]); o.y = pk2(s[2 * 33], s[3 * 33]); o.z = pk2(s[4 * 33], s[5 * 33]); o.w = pk2(s[6 * 33], s[7 * 33]);
        *(v4u*)(d.WT + (size_t)(d.n0 + n) * d.K + d.k0 + 8 * c) = o; }
    LDS_WAIT(); asm volatile("" ::: "memory");
}
__device__ __constant__ float ROPE_INV[32] = {1.f, 0.749894202f, 0.562341332f, 0.421696514f, 0.316227764f, 0.237137377f, 0.177827939f, 0.133352146f, 0.100000001f, 0.0749894232f, 0.0562341325f, 0.0421696492f,
    0.0316227749f, 0.0237137377f, 0.0177827943f, 0.013335214f, 0.00999999978f, 0.00749894232f, 0.00562341325f, 0.00421696482f, 0.00316227763f, 0.00237137382f, 0.00177827943f, 0.00133352145f, 0.00100000005f,
    0.000749894185f, 0.000562341302f, 0.000421696517f, 0.000316227757f, 0.00023713737f, 0.00017782794f, 0.00013335215f};

__device__ __forceinline__ void p0_prologue(Frame& F) {
    float* scr = (float*)(F.lds + F.wave * 16384);
    KArgs ka = kargs();
    const float *Fx = ka->in[I_X], *Fmeta = ka->in[I_META], *Fnorm1_g = ka->in[I_NORM1G], *Fw_in = ka->in[I_WIN], *Fw_out = ka->in[I_WOUT], *Fnorm2_g = ka->in[I_NORM2G], *Fw_gate_up = ka->in[I_WGU], *Fw_down = ka->in[I_WDN];
    const int gw = F.vcu * NWAVES + F.wave, NGW = F.G * NWAVES;
    constexpr int I_IN = (1024 / 64) * (NIN / 32), I_OUT = (1024 / 64) * (1024 / 32), I_GU = (1024 / 64) * (NGU / 32), I_DN = (DFF / 64) * (1024 / 32), I_L = I_IN + I_OUT + I_GU + I_DN;
    {
        auto decode = [&](int it) -> TrItem { TrItem d; const int l = it / I_L; int r = it % I_L; bf16* wl = (bf16*)(F.ws + OFF_W + (size_t)l * SZ_WL); int map;
            if (r < I_IN) { d.W = Fw_in + (size_t)l * 1024 * NIN; d.K = 1024; d.N = NIN; d.WT = wl; d.gain = Fnorm1_g + l * 1024; map = 1; }
            else if ((r -= I_IN) < I_OUT) { d.W = Fw_out + (size_t)l * 1024 * 1024; d.K = 1024; d.N = 1024; d.WT = (bf16*)((unsigned char*)wl + SZ_WIN); d.gain = nullptr; map = 0; }
            else if ((r -= I_OUT) < I_GU) { d.W = Fw_gate_up + (size_t)l * 1024 * NGU; d.K = 1024; d.N = NGU; d.WT = (bf16*)((unsigned char*)wl + SZ_WIN + SZ_WOUT); d.gain = Fnorm2_g + l * 1024; map = 2; }
            else { r -= I_GU; d.W = Fw_down + (size_t)l * DFF * 1024; d.K = DFF; d.N = 1024; d.WT = (bf16*)((unsigned char*)wl + SZ_WIN + SZ_WOUT + SZ_WGU); d.gain = nullptr; map = 0; }
            const int nblk = d.N / 32; d.k0 = 64 * (r / nblk); d.n0 = 32 * (r % nblk); d.f0 = featmap(map, d.n0); return d; };
        f32x4 v[8], vn[8]; float gk[8], gkn[8]; int it = gw; TrItem d, dn;
        if (it < DEPTH * I_L) { d = decode(it); tr_load(d, F.lane, v, gk); }
        while (it < DEPTH * I_L) {
            const int itn = it + NGW;
            if (itn < DEPTH * I_L) { dn = decode(itn); tr_load(dn, F.lane, vn, gkn); }
            tr_store(d, F.lane, v, gk, scr);
#pragma unroll
            for (int i = 0; i < 8; ++i) { v[i] = vn[i]; gk[i] = gkn[i]; }
            d = dn; it = itn;
        }
    }
    bf16* HB = (bf16*)(F.ws + OFF_HB); float* SS = (float*)(F.ws + OFF_SS);
    {
        f32x4 v[4], vn[4]; int m = gw;
#define P0_LOADROW(dst, mm) do { const float* src_ = (mm) < MX ? Fx + (size_t)(mm) * 1024 : Fmeta + (size_t)((mm) - MX) * 1024; \
            _Pragma("unroll") for (int j = 0; j < 4; ++j) dst[j] = ((const f32x4*)src_)[F.lane + 64 * j]; } while (0)
        if (m < MX + NMETA) P0_LOADROW(v, m);
        while (m < MX + NMETA) {
            const int mn = m + NGW;
            if (mn < MX + NMETA) P0_LOADROW(vn, mn);
            float s = 0.f;
#pragma unroll
            for (int j = 0; j < 4; ++j) s += (v[j].x * v[j].x + v[j].y * v[j].y) + (v[j].z * v[j].z + v[j].w * v[j].w);
            s = wave_sum(s);
#pragma unroll
            for (int j = 0; j < 4; ++j) { v2u o; o.x = pk2(v[j].x, v[j].y); o.y = pk2(v[j].z, v[j].w); ((v2u*)(HB + (size_t)m * 1024))[F.lane + 64 * j] = o; }
            if (F.lane < 16) SS[(size_t)m * 16 + F.lane] = F.lane == 0 ? s : 0.f;
#pragma unroll
            for (int j = 0; j < 4; ++j) v[j] = vn[j];
            m = mn;
        }
#undef P0_LOADROW
    }
    float* RC = (float*)(F.ws + OFF_ROPEC); float* RS = (float*)(F.ws + OFF_ROPES);
    for (int idx = (F.vcu * NWAVES + F.wave) * 64 + F.lane; idx < (SEQ + NMETA) * 32; idx += F.G * NWAVES * 64) {
        const int p = idx >> 5, i = idx & 31; const float ang = (float)p * ROPE_INV[i];
        const double a = (double)ang; const double kq = __builtin_rint(a * 0.15915494309189535); const float r = (float)(a - kq * 6.283185307179586);
        RC[idx] = cosf(r); RS[idx] = sinf(r);
    }
    if (blockIdx.x == 0 && F.tid < DEPTH) { const int l = F.tid; float s1 = 0.f, s2 = 0.f;
        for (int i = 0; i < 64; ++i) { s1 += ka->in[I_LQ1][l * 64 + i] * ka->in[I_LK1][l * 64 + i]; s2 += ka->in[I_LQ2][l * 64 + i] * ka->in[I_LK2][l * 64 + i]; }
        const float lam_init = 0.8f - 0.6f * expf(-0.3f * (float)l);
        float* ctl = (float*)(F.ws + OFF_CTL); ctl[CW_LAM + 2 * l] = expf(s1) - expf(s2) + lam_init; ctl[CW_LAM + 2 * l + 1] = 1.0f - lam_init; }
}

__device__ __forceinline__ void meta_attn(const bf16* Q, const bf16* K, const bf16* V, bf16* O, int vh, float* sm, int tid) {
    float* sq = sm; float* sk = sm + 1024; float* sv = sk + 16 * 65; float* sc = sv + 1024;
    const int qcol = (vh >> 1) * 64, vcol = (vh >> 2) * 128 + (vh & 1) * 64;
    for (int idx = tid; idx < 1024; idx += 512) { const int i = idx >> 6, d = idx & 63;
        sq[idx] = bf1(Q[(size_t)(MX + i) * 512 + qcol + d]); sk[i * 65 + d] = bf1(K[(size_t)(MX + i) * 512 + qcol + d]); sv[idx] = bf1(V[(size_t)(MX + i) * 512 + vcol + d]); }
    LDS_BARRIER();
    if (tid < 256) { const int i = tid >> 4, j = tid & 15; float s = 0.f;
        for (int d = 0; d < 64; ++d) s += sq[i * 64 + d] * sk[j * 65 + d];
        sc[tid] = s; }
    LDS_BARRIER();
    { const int i = tid >> 5, d = (tid & 31) * 2; float m = -INFINITY;
      for (int j = 0; j <= i; ++j) m = fmaxf(m, sc[i * 16 + j]);
      float l = 0.f, o0 = 0.f, o1 = 0.f;
      for (int j = 0; j <= i; ++j) { const float p = exp2f(sc[i * 16 + j] - m); l += p; o0 += p * sv[j * 64 + d]; o1 += p * sv[j * 64 + d + 1]; }
      const float rl = 1.0f / l;
      *(unsigned*)(O + (size_t)(MX + i) * 1024 + vh * 64 + d) = pk2(o0 * rl, o1 * rl); }
    LDS_BARRIER();
}

__device__ __forceinline__ void mix_phase(Frame& F, int l) {
    const bf16* O = (const bf16*)(F.ws + OFF_O); const bf16* Z = (const bf16*)(F.ws + OFF_Z); bf16* MIX = (bf16*)(F.ws + OFF_MIX);
    const float* ctl = (const float*)(F.ws + OFF_CTL); const float lam = ctl[CW_LAM + 2 * l], osc = ctl[CW_LAM + 2 * l + 1];
    KArgs ka = kargs();
    const float* subg = ka->in[I_SUBG] + l * 128; const float* cw = ka->in[I_CONVW] + (size_t)l * CONVW * CCH; const float* cb = ka->in[I_CONVB] + l * CCH;
    const float* lg = ka->in[I_CLNG] + l * CCH; const float* lb = ka->in[I_CLNB] + l * CCH;
    f32x2* red0 = (f32x2*)F.lds;
    int parity = 0;
    const int lane = F.lane, w = F.wave;
    const int tg = w >> 2, cbk = w & 3, c0 = cbk * 128 + 2 * lane;
    f32x2 wk[CONVW];
#pragma unroll
    for (int k = 0; k < CONVW; ++k) wk[k] = *(const f32x2*)(cw + k * CCH + c0);
    const f32x2 bb = *(const f32x2*)(cb + c0), gg = *(const f32x2*)(lg + c0), gb = *(const f32x2*)(lb + c0);
    const int h = lane >> 4, e0 = (lane & 15) * 8, half = e0 >> 6, ec = e0 & 63;
    const f32x4 g0 = *(const f32x4*)(subg + e0), g1 = *(const f32x4*)(subg + e0 + 4);
#define MIX_LOAD(IT, ZW, OA, OB) do { const bool meta_ = (IT) == 2048; const int r0_ = meta_ ? MX : (IT) * 16, rg_ = r0_ + 8 * tg, pg_ = meta_ ? 8 * tg : 16 + (rg_ & 8191), rb_ = rg_ & ~8191; \
        _Pragma("unroll") for (int j = 0; j < 38; ++j) { const int pp = pg_ - 30 + j; ZW[j] = 0u; \
            if (pp >= 0) { const int zr = (meta_ || pp < 16) ? MX + pp : rb_ + pp - 16; ZW[j] = *(const unsigned*)(Z + (size_t)zr * 512 + c0); } } \
        _Pragma("unroll") for (int rr = 0; rr < 2; ++rr) { const int row = r0_ + 2 * w + rr; \
            OA[rr] = *(const v4u*)(O + (size_t)row * 1024 + (h * 4 + half) * 64 + ec); OB[rr] = *(const v4u*)(O + (size_t)row * 1024 + (h * 4 + 2 + half) * 64 + ec); } } while (0)
    unsigned zwv[38], zwn[38]; v4u oa[2], ob[2], oan[2], obn[2];
    if (F.vcu < 2049) MIX_LOAD(F.vcu, zwv, oa, ob);
    for (int it = F.vcu; it < 2049; it += F.G) {
        const bool meta = it == 2048; const int r0 = meta ? MX : it * 16;
        f32x2* red = red0 + parity * 64; parity ^= 1;
        const int rg = r0 + 8 * tg;
        if (it + F.G < 2049) MIX_LOAD(it + F.G, zwn, oan, obn);
        {
#pragma unroll
            for (int rr = 0; rr < 2; ++rr) { const int row = r0 + 2 * w + rr;
                const v4u a = oa[rr], b = ob[rr];
                f32x4 d0, d1;
                d0[0] = bflo(a.x) - lam * bflo(b.x); d0[1] = bfhi(a.x) - lam * bfhi(b.x); d0[2] = bflo(a.y) - lam * bflo(b.y); d0[3] = bfhi(a.y) - lam * bfhi(b.y);
                d1[0] = bflo(a.z) - lam * bflo(b.z); d1[1] = bfhi(a.z) - lam * bfhi(b.z); d1[2] = bflo(a.w) - lam * bflo(b.w); d1[3] = bfhi(a.w) - lam * bfhi(b.w);
                float ss = ((d0[0] * d0[0] + d0[1] * d0[1]) + (d0[2] * d0[2] + d0[3] * d0[3])) + ((d1[0] * d1[0] + d1[1] * d1[1]) + (d1[2] * d1[2] + d1[3] * d1[3]));
                ss = row16_sum(ss);
                const float r = __builtin_amdgcn_rsqf(ss * (1.0f / 128.0f) + 1e-5f) * osc;
                d0 = d0 * r * g0; d1 = d1 * r * g1;
                v4u o; o.x = pk2(d0[0], d0[1]); o.y = pk2(d0[2], d0[3]); o.z = pk2(d1[0], d1[1]); o.w = pk2(d1[2], d1[3]);
                *(v4u*)(MIX + (size_t)row * 1024 + h * 128 + e0) = o; }
        }
        {
            f32x2 accv[8];
            for (int rep_ = 0; rep_ < (PROBE_DUP == 12 ? 3 : 1); ++rep_) {
            if (PROBE_DUP == 12) asm volatile("" : "+v"(zwv[0]), "+v"(zwv[37]));
#pragma unroll
            for (int t = 0; t < 8; ++t) accv[t] = (f32x2){0.f, 0.f};
#pragma unroll
            for (int j = 0; j < 38; ++j) { const unsigned zw = zwv[j];
                const f32x2 zz = {bflo(zw), bfhi(zw)};
#pragma unroll
                for (int t = 0; t < 8; ++t) { const int k = j - t; if (k >= 0 && k < CONVW) accv[t] = __builtin_elementwise_fma(zz, wk[k], accv[t]); }
            }
            }
            float acc0[8], acc1[8], s1[8], s2[8];
#pragma unroll
            for (int t = 0; t < 8; ++t) { acc0[t] = accv[t].x + bb.x; acc1[t] = accv[t].y + bb.y; s1[t] = acc0[t] + acc1[t]; s2[t] = acc0[t] * acc0[t] + acc1[t] * acc1[t]; }
#pragma unroll
            for (int t = 0; t < 8; ++t) { s1[t] = wave_sum(s1[t]); s2[t] = wave_sum(s2[t]); }
            if (lane == 0) {
#pragma unroll
                for (int t = 0; t < 8; ++t) red[(tg * 8 + t) * 4 + cbk] = (f32x2){s1[t], s2[t]};
            }
            LDS_BARRIER();
#pragma unroll
            for (int t = 0; t < 8; ++t) { const f32x2 p0 = red[(tg * 8 + t) * 4 + 0], p1 = red[(tg * 8 + t) * 4 + 1], p2 = red[(tg * 8 + t) * 4 + 2], p3 = red[(tg * 8 + t) * 4 + 3];
                const float mu = ((p0.x + p1.x) + (p2.x + p3.x)) * (1.0f / 512.0f); const float var = ((p0.y + p1.y) + (p2.y + p3.y)) * (1.0f / 512.0f) - mu * mu;
                const float rstd = __builtin_amdgcn_rsqf(fmaxf(var, 0.f) + 1e-5f);
                const float y0 = (acc0[t] - mu) * rstd * gg.x + gb.x, y1 = (acc1[t] - mu) * rstd * gg.y + gb.y;
                const float o0 = y0 * __builtin_amdgcn_rcpf(1.f + __expf(-y0)), o1 = y1 * __builtin_amdgcn_rcpf(1.f + __expf(-y1));
                *(unsigned*)(MIX + (size_t)(rg + t) * 1024 + 512 + c0) = pk2(o0, o1); }
        }
#pragma unroll
        for (int j = 0; j < 38; ++j) zwv[j] = zwn[j];
#pragma unroll
        for (int rr = 0; rr < 2; ++rr) { oa[rr] = oan[rr]; ob[rr] = obn[rr]; }
    }
#undef MIX_LOAD
}

__device__ __forceinline__ void final_phase(Frame& F) {
    const bf16* HB = (const bf16*)(F.ws + OFF_HB); const float* SS = (const float*)(F.ws + OFF_SS);
    const int gw = F.vcu * NWAVES + F.wave, NGW = F.G * NWAVES;
    KArgs ka = kargs(); const float* fg = ka->in[I_FINALG]; float* out = ka->out;
    f32x4 g[4];
#pragma unroll
    for (int j = 0; j < 4; ++j) g[j] = ((const f32x4*)fg)[F.lane + 64 * j];
    {
        v2u w[4], wn[4]; f32x4 sq[4], sqn[4]; int m = gw;
#define FIN_LOAD(W, Q, mm) do { _Pragma("unroll") for (int j = 0; j < 4; ++j) { Q[j] = ((const f32x4*)(SS + (size_t)(mm) * 16))[j]; W[j] = ((const v2u*)(HB + (size_t)(mm) * 1024))[F.lane + 64 * j]; } } while (0)
        if (m < MX) FIN_LOAD(w, sq, m);
        while (m < MX) {
            const int mn = m + NGW;
            if (mn < MX) FIN_LOAD(wn, sqn, mn);
            const f32x4 t = (sq[0] + sq[1]) + (sq[2] + sq[3]);
            const float rs = __builtin_amdgcn_rsqf(((t[0] + t[1]) + (t[2] + t[3])) * (1.0f / 1024.0f) + 1e-5f);
#pragma unroll
            for (int j = 0; j < 4; ++j) { const f32x4 v = {bflo(w[j].x), bfhi(w[j].x), bflo(w[j].y), bfhi(w[j].y)}; ((f32x4*)(out + (size_t)m * 1024))[F.lane + 64 * j] = v * rs * g[j]; }
#pragma unroll
            for (int j = 0; j < 4; ++j) { w[j] = wn[j]; sq[j] = sqn[j]; }
            m = mn;
        }
#undef FIN_LOAD
    }
}

#define RLX_AGENT __ATOMIC_RELAXED, __HIP_MEMORY_SCOPE_AGENT
#define XB_TMO      128
#define XB_XCNT(j)  (256  + 64 * (j))
#define XB_XSUB(j)  (1280 + 64 * (j))
#define XB_XGEN(j)  (2304 + 64 * (j))
#define XB_TOP      3328
#define XB_TOPGEN   3392
#define XCD_BAR_WORDS 3456
#define XB_SPIN_CAP (1u << 18)

__device__ __forceinline__ unsigned xb_ld(unsigned* p)              { return __hip_atomic_load(p, __ATOMIC_RELAXED, __HIP_MEMORY_SCOPE_AGENT); }
__device__ __forceinline__ unsigned xb_add(unsigned* p, unsigned v) { return __hip_atomic_fetch_add(p, v, __ATOMIC_RELAXED, __HIP_MEMORY_SCOPE_AGENT); }
__device__ __forceinline__ unsigned xb_xcc_id() { return (unsigned)__builtin_amdgcn_s_getreg((3 << 11) | 20) & 0xFu; }
#define XB_SPIN(cond, bar) do { unsigned _sp = 0; while (cond) { __builtin_amdgcn_s_sleep(1); \
    if ((++_sp & 255u) == 0u) { if (xb_ld(&(bar)[XB_TMO])) break; if (_sp > XB_SPIN_CAP) { atomicAdd(&(bar)[XB_TMO], 1u); break; } } } } while (0)

struct XcdBarrier {
    unsigned* bar; unsigned x;
    volatile LAS unsigned* st;
};

__device__ __forceinline__ XcdBarrier xcd_barrier_post(unsigned* bar, volatile LAS unsigned* st) {
    XcdBarrier b; b.bar = bar; b.x = xb_xcc_id(); b.st = st;
    if (threadIdx.x == 0) (void)xb_add(&bar[XB_XCNT(b.x)], 1u);
    return b;
}
__device__ __forceinline__ void xcd_barrier_complete(unsigned* bar, unsigned x, unsigned& nloc, unsigned& nx) {
    const unsigned G = gridDim.x * gridDim.y * gridDim.z;
    unsigned sum, cnt, mine, sp = 0u;
    for (;;) {
        sum = 0u; cnt = 0u; mine = 0u;
#pragma unroll
        for (unsigned j = 0; j < 16; ++j) { const unsigned c = xb_ld(&bar[XB_XCNT(j)]); sum += c; cnt += (c > 0u) ? 1u : 0u; mine = (j == x) ? c : mine; }
        if (sum == G) break;
        __builtin_amdgcn_s_sleep(1);
        if ((++sp & 255u) == 0u) { if (xb_ld(&bar[XB_TMO])) break; if (sp > XB_SPIN_CAP) { atomicAdd(&bar[XB_TMO], 1u); break; } }
    }
    nloc = mine > 0u ? mine : 1u; nx = cnt > 0u ? cnt : 1u;
}

__device__ __forceinline__ void xcd_barrier(const XcdBarrier& b) {
    asm volatile("s_waitcnt vmcnt(0)" ::: "memory");
    __syncthreads();
    if (threadIdx.x == 0) {
        unsigned* bar = b.bar;
        __builtin_amdgcn_s_waitcnt(0);
        unsigned nloc = b.st[0], nx = b.st[1];
        if (nloc == 0u) { xcd_barrier_complete(bar, b.x, nloc, nx); b.st[0] = nloc; b.st[1] = nx; }
        const unsigned old = xb_add(&bar[XB_XSUB(b.x)], 1u);
        const unsigned gen = old / nloc;
        if (old + 1u == (gen + 1u) * nloc) {
            __builtin_amdgcn_fence(__ATOMIC_RELEASE, "agent");
            asm volatile("s_waitcnt vmcnt(0)" ::: "memory");
            const unsigned og = xb_add(&bar[XB_TOP], 1u);
            const unsigned tg = og / nx;
            if (og + 1u == (tg + 1u) * nx) xb_add(&bar[XB_TOPGEN], 1u);
            else XB_SPIN(xb_ld(&bar[XB_TOPGEN]) == tg, bar);
            __builtin_amdgcn_fence(__ATOMIC_ACQUIRE, "agent");
            xb_add(&bar[XB_XGEN(b.x)], 1u);
            asm volatile("s_waitcnt vmcnt(0)" ::: "memory");
        } else {
            XB_SPIN(xb_ld(&bar[XB_XGEN(b.x)]) == gen, bar);
            __builtin_amdgcn_fence(__ATOMIC_ACQUIRE, "agent");
            asm volatile("s_waitcnt vmcnt(0)" ::: "memory");
        }
    }
    __syncthreads();
}

constexpr int CW_BAR = 4096;
constexpr int LDS_XB = 147440;

constexpr int LDS_RL = 131072;
template <class Sched> __device__ __forceinline__ void rstd_table(unsigned char* lds, const Sched& S, const float* SS, int tid) {
    LAS float* rl = (LAS float*)((LAS unsigned char*)lds + LDS_RL);
    int pmv[7]; bool ok[7];
#pragma unroll
    for (int j = 0; j < 7; ++j) { pg8::Unit u; u.pm = 0; u.pn = 0; ok[j] = S.next((tid + 512 * j) >> 8, u); pmv[j] = u.pm; }
    float rv[7];
#pragma unroll
    for (int j = 0; j < 7; ++j) rv[j] = ok[j] ? pg8::row_rstd(SS, pmv[j] * 256 + (tid & 255)) : 0.f;
#pragma unroll
    for (int j = 0; j < 7; ++j) if (ok[j]) rl[tid + 512 * j] = rv[j];
    LDS_BARRIER();
}

template <class Epi> __device__ __forceinline__ void mini_gemm(unsigned char* lds, const pg8::bf16_t* A, const pg8::bf16_t* Bt, int K, const Epi& E, int task, int tid) {
    typedef short bf16x8_t __attribute__((ext_vector_type(8)));
    const int lane = tid & 63, wid = __builtin_amdgcn_readfirstlane(tid >> 6), fr = lane & 15, fq = lane >> 4;
    const int pn = task >> 2, wc = task & 3;
    const int kw = K >> 3, kbeg = wid * kw;
    const pg8::bf16_t* ap = A + (size_t)(MX + fr) * K + kbeg + 8 * fq;
    const pg8::bf16_t* bp = Bt + (size_t)(pn * 256 + wc * 32 + 8 * (fr >> 2) + (fr & 3)) * K + kbeg + 8 * fq;
    f32x4 acc[2][2];
#pragma unroll
    for (int bj = 0; bj < 2; ++bj)
#pragma unroll
        for (int n = 0; n < 2; ++n) acc[bj][n] = (f32x4){0.f, 0.f, 0.f, 0.f};
    for (int k0 = 0; k0 < kw; k0 += 128) {
        bf16x8_t a[4], b[4][2][2];
#pragma unroll
        for (int s = 0; s < 4; ++s) { const bool ok = k0 + 32 * s < kw; const int kk = ok ? k0 + 32 * s : 0;
            a[s] = *(const bf16x8_t*)(ap + kk);
#pragma unroll
            for (int bj = 0; bj < 2; ++bj)
#pragma unroll
                for (int n = 0; n < 2; ++n) b[s][bj][n] = *(const bf16x8_t*)(bp + (size_t)(128 * bj + 4 * n) * K + kk); }
        asm volatile("" : "+v"(a[0]), "+v"(a[1]), "+v"(a[2]), "+v"(a[3]), "+v"(b[0][0][0]), "+v"(b[0][0][1]), "+v"(b[0][1][0]), "+v"(b[0][1][1]), "+v"(b[1][0][0]), "+v"(b[1][0][1]), "+v"(b[1][1][0]), "+v"(b[1][1][1]),
                     "+v"(b[2][0][0]), "+v"(b[2][0][1]), "+v"(b[2][1][0]), "+v"(b[2][1][1]), "+v"(b[3][0][0]), "+v"(b[3][0][1]), "+v"(b[3][1][0]), "+v"(b[3][1][1]));
#pragma unroll
        for (int s = 0; s < 4; ++s) { const bool ok = k0 + 32 * s < kw; const bf16x8_t as = ok ? a[s] : (bf16x8_t){0, 0, 0, 0, 0, 0, 0, 0};
#pragma unroll
            for (int bj = 0; bj < 2; ++bj)
#pragma unroll
                for (int n = 0; n < 2; ++n) acc[bj][n] = __builtin_amdgcn_mfma_f32_16x16x32_bf16(b[s][bj][n], as, acc[bj][n], 0, 0, 0); }
    }
    f32x4* red = (f32x4*)lds;
#pragma unroll
    for (int bj = 0; bj < 2; ++bj)
#pragma unroll
        for (int n = 0; n < 2; ++n) red[(wid * 4 + bj * 2 + n) * 64 + lane] = acc[bj][n];
    LDS_BARRIER();
    if (wid == 0) {
        f32x4 sm[4];
#pragma unroll
        for (int q = 0; q < 4; ++q) { sm[q] = red[q * 64 + lane];
#pragma unroll
            for (int w = 1; w < 8; ++w) sm[q] = sm[q] + red[(w * 4 + q) * 64 + lane]; }
        E.rg(sm[0], sm[1], sm[2], sm[3], MX + fr, pn, wc, fq);
    }
    LDS_BARRIER();
}

__global__ void __launch_bounds__(NWAVES * 64, 2) mk_fwd(Args args) {
    extern __shared__ __attribute__((aligned(16))) unsigned char lds[];
    cg::grid_group grid = cg::this_grid();
    if (threadIdx.x < 2) ((volatile LAS unsigned*)((LAS unsigned char*)lds + LDS_XB))[threadIdx.x] = 0u;
    __syncthreads();
    if (!MK_PER_PHASE) (void)xcd_barrier_post((unsigned*)(args.ws + OFF_CTL) + CW_BAR, (volatile LAS unsigned*)((LAS unsigned char*)lds + LDS_XB));
    for (int vp = args.ph_lo; vp < args.ph_hi; ++vp) {
        Frame F;
        { int tid_ = threadIdx.x; asm volatile("" : "+v"(tid_)); F.tid = tid_; }
        unsigned char* ws = kargs()->ws;
        pg8::bf16_t* HB = (pg8::bf16_t*)(ws + OFF_HB); float* SS = (float*)(ws + OFF_SS);
        pg8::bf16_t* Qb = (pg8::bf16_t*)(ws + OFF_Q); pg8::bf16_t* Kb = (pg8::bf16_t*)(ws + OFF_K); pg8::bf16_t* Vb = (pg8::bf16_t*)(ws + OFF_V); pg8::bf16_t* Zb = (pg8::bf16_t*)(ws + OFF_Z);
        pg8::bf16_t* Ob = (pg8::bf16_t*)(ws + OFF_O); pg8::bf16_t* MIX = (pg8::bf16_t*)(ws + OFF_MIX); pg8::bf16_t* ACT = (pg8::bf16_t*)(ws + OFF_ACT);
        LAS unsigned char* lds3 = (LAS unsigned char*)lds;
        F.lds = lds; F.lane = F.tid & 63; F.wave = __builtin_amdgcn_readfirstlane(F.tid >> 6); F.ws = ws;
        F.G = gridDim.x; { const int bx = blockIdx.x; F.vcu = (F.G % 8 == 0) ? (bx % 8) * (F.G / 8) + bx / 8 : bx; }
        if (vp == 0) { p0_prologue(F); if (PROBE_DUP == 6) p0_prologue(F); }
        else if (vp == NVPH - 1) { final_phase(F); if (PROBE_DUP == 8) final_phase(F); }
        else {
            const int l = (vp - 1) / NSLOT, slot = (vp - 1) % NSLOT, sub = (PROBE_DUP >= 0 && PROBE_DUP < 6 && slot > PROBE_DUP) ? slot - 1 : slot;
            const unsigned char* wl = ws + OFF_W + (size_t)l * SZ_WL;
            if (sub == 0) {
                pg8::Gemm g{HB, (const pg8::bf16_t*)wl, MX, NIN, 1024}; pg8::StaticOrder S; S.init(MX, NIN, F.G, (int)blockIdx.x); if (PROBE_DUP == 10) S.rep = 2;
                pg8::EpiQKVZ E{Qb, Kb, Vb, Zb, SS, (const float*)(ws + OFF_ROPEC), (const float*)(ws + OFF_ROPES), kargs()->in[I_BGLU] + l * 1024, (const LAS float*)(lds3 + LDS_RL)};
                rstd_table(lds, S, SS, F.tid);
                pg8::gemm_phase<pg8::EpiQKVZ, pg8::StaticOrder, true, true>(lds3, g, S, E);
                if (F.vcu < NIN / 64) { for (int rep_ = 0; rep_ < (PROBE_DUP == 9 ? 5 : 1); ++rep_) mini_gemm(lds, g.A, g.Bt, 1024, E, F.vcu, F.tid); }
                if (F.vcu == 255) { for (int i = F.tid; i < 48 * 64; i += NWAVES * 64) ((v4u*)(Vb + (size_t)(MX + 16) * 512))[i] = (v4u){0u, 0u, 0u, 0u}; }
            } else if (sub == 1) {
                if (F.vcu < 16) meta_attn((const bf16*)Qb, (const bf16*)Kb, (const bf16*)Vb, (bf16*)Ob, F.vcu, (float*)lds, F.tid);
                const attn_body::AttnTensors AT{(const attn_body::bf16*)Qb, (const attn_body::bf16*)Kb, (const attn_body::bf16*)Vb, (attn_body::bf16*)Ob};
                const attn_body::StaticOrder S(F.vcu);
                attn_body::attn_phase<attn_body::StaticOrder>((char*)lds, AT, S);
            } else if (sub == 2) {
                mix_phase(F, l);
            } else if (sub == 3) {
                pg8::Gemm g{MIX, (const pg8::bf16_t*)(wl + SZ_WIN), MX, 1024, 1024}; pg8::StaticOrder S; S.init(MX, 1024, F.G, (int)blockIdx.x);
                pg8::EpiResid E{HB, SS};
                pg8::gemm_phase<pg8::EpiResid, pg8::StaticOrder, true, true>(lds3, g, S, E);
                if (F.vcu < 1024 / 64) mini_gemm(lds, g.A, g.Bt, 1024, E, F.vcu, F.tid);
            } else if (sub == 4) {
                pg8::Gemm g{HB, (const pg8::bf16_t*)(wl + SZ_WIN + SZ_WOUT), MX, NGU, 1024}; pg8::StaticOrder S; S.init(MX, NGU, F.G, (int)blockIdx.x); if (PROBE_DUP == 11) S.rep = 2;
                pg8::EpiSwiGLU E{ACT, SS, (const LAS float*)(lds3 + LDS_RL)};
                rstd_table(lds, S, SS, F.tid);
                pg8::gemm_phase<pg8::EpiSwiGLU, pg8::StaticOrder, true, true>(lds3, g, S, E);
                if (F.vcu < NGU / 64) mini_gemm(lds, g.A, g.Bt, 1024, E, F.vcu, F.tid);
            } else {
                pg8::Gemm g{ACT, (const pg8::bf16_t*)(wl + SZ_WIN + SZ_WOUT + SZ_WGU), MX, 1024, DFF}; pg8::StaticOrder S; S.init(MX, 1024, F.G, (int)blockIdx.x);
                pg8::EpiResid E{HB, SS};
                pg8::gemm_phase<pg8::EpiResid, pg8::StaticOrder, true, true>(lds3, g, S, E);
                if (F.vcu < 1024 / 64) mini_gemm(lds, g.A, g.Bt, DFF, E, F.vcu, F.tid);
            }
        }
        if (vp + 1 < args.ph_hi) {
            if (args.ph_lo < 0) grid.sync();
            { XcdBarrier xb; xb.bar = (unsigned*)(kargs()->ws + OFF_CTL) + CW_BAR; xb.x = xb_xcc_id(); xb.st = (volatile LAS unsigned*)((LAS unsigned char*)lds + LDS_XB); xcd_barrier(xb); if (PROBE_DUP == 7) xcd_barrier(xb); }
        }
    }
}

extern "C" void kernel_launch(void* const* d_in, const int* in_sizes, int n_in, void* d_out, int out_size, void* d_ws, size_t ws_size, hipStream_t stream) {
    static int grid = 0;
    if (grid == 0) {
        if (n_in != 19 || in_sizes[0] != MX * 1024 || out_size != MX * 1024 || ws_size < WS_END) { fprintf(stderr, "kernel_launch: unexpected shapes (n_in %d, in0 %d, out %d, ws %zu < %zu)\n", n_in, n_in > 0 ? in_sizes[0] : -1, out_size, ws_size, (size_t)WS_END); grid = -1; return; }
        int dev = 0, cus = 0, per_cu = 0;
        if (hipGetDevice(&dev) != hipSuccess || hipDeviceGetAttribute(&cus, hipDeviceAttributeMultiprocessorCount, dev) != hipSuccess) { grid = -1; return; }
        if (hipFuncSetAttribute((const void*)mk_fwd, hipFuncAttributeMaxDynamicSharedMemorySize, LDS_BYTES) != hipSuccess) { fprintf(stderr, "kernel_launch: hipFuncSetAttribute failed\n"); grid = -1; return; }
        if (hipOccupancyMaxActiveBlocksPerMultiprocessor(&per_cu, (const void*)mk_fwd, NWAVES * 64, LDS_BYTES) != hipSuccess || per_cu < 1) { fprintf(stderr, "kernel_launch: occupancy query says %d\n", per_cu); per_cu = 1; }
        (void)hipGetLastError();
        grid = cus;
        if (grid != 256) fprintf(stderr, "kernel_launch: %d CUs; the attention schedule assumes 256\n", grid);
    }
    if (grid < 0) return;
    Args a{};
    for (int i = 0; i < 19; ++i) a.in[i] = (const float*)d_in[i];
    a.out = (float*)d_out; a.ws = (unsigned char*)d_ws;
#if MK_PER_PHASE
    for (int ph = 0; ph < NVPH; ++ph) { a.ph_lo = ph; a.ph_hi = ph + 1; hipLaunchKernelGGL(mk_fwd, dim3(grid), dim3(NWAVES * 64), LDS_BYTES, stream, a); }
#else
    a.ph_lo = 0; a.ph_hi = NVPH;
    if (hipMemsetAsync((char*)d_ws + OFF_CTL + (size_t)CW_BAR * 4, 0, (size_t)XCD_BAR_WORDS * 4, stream) != hipSuccess) { fprintf(stderr, "kernel_launch: memset of the barrier words failed\n"); return; }
    void* kargs[] = {&a};
    hipError_t e = hipLaunchCooperativeKernel((const void*)mk_fwd, dim3(grid), dim3(NWAVES * 64), kargs, LDS_BYTES, stream);
    if (e != hipSuccess) fprintf(stderr, "kernel_launch: cooperative launch failed: %s (grid %d)\n", hipGetErrorString(e), grid);
#endif
}
```
